# Optimizing an MI355X kernel written in HIP

```python
import jax, jax.numpy as jnp
from jax import lax
import numpy as np

D_MODEL = 1024
BATCH = 8
SEQ = 8192
DEPTH = 1

HEAD_DIM = 64
ROT_DIM = HEAD_DIM // 4
ROPE_THETA = 500000.0
BLOCK = 128
A_Q_HEADS = 16
A_KV_HEADS = 4
A_WINDOW = 128
B_GROUPS = ((128, 1), (512, 4), (2048, 16))
B_NG = len(B_GROUPS)
B_HEADS_PER_GROUP = 4
B_HEADS = B_NG * B_HEADS_PER_GROUP
A_Q_W = A_Q_HEADS * HEAD_DIM
A_KV_W = A_KV_HEADS * HEAD_DIM
B_W = B_HEADS * HEAD_DIM
SPLITS = (A_Q_W, A_Q_W + A_KV_W, A_Q_W + 2 * A_KV_W, A_Q_W + 2 * A_KV_W + B_W, A_Q_W + 2 * A_KV_W + 2 * B_W)
IN_W = A_Q_W + 2 * A_KV_W + 3 * B_W
A_OUT_W = A_Q_W
B_OUT_W = B_HEADS_PER_GROUP * HEAD_DIM
N_BRANCH = 2
D_FF = ((8 * D_MODEL // 3 + 255) // 256) * 256
DN_ALPHA = (2 * DEPTH) ** 0.25
DN_BETA = (8 * DEPTH) ** -0.25
LN_EPS = 1e-5
NEG = -1e30

kernel_name = "hybrid_gated_window_dilated_encoder_layer"


def layer_norm(x, g, b):
    xf = x.astype(jnp.float32)
    mu = xf.mean(-1, keepdims=True)
    var = jnp.square(xf - mu).mean(-1, keepdims=True)
    return ((xf - mu) * lax.rsqrt(var + LN_EPS) * g.astype(jnp.float32) + b.astype(jnp.float32)).astype(x.dtype)


def rope_partial(t, pos):
    half = ROT_DIM // 2
    inv = ROPE_THETA ** (-jnp.arange(half, dtype=jnp.float32) / half)
    ang = pos.astype(jnp.float32)[:, None] * inv[None, :]
    cos = jnp.cos(ang)[None, :, None, :].astype(t.dtype)
    sin = jnp.sin(ang)[None, :, None, :].astype(t.dtype)
    t1, t2, tp = t[..., :half], t[..., half:ROT_DIM], t[..., ROT_DIM:]
    return jnp.concatenate([t1 * cos - t2 * sin, t1 * sin + t2 * cos, tp], axis=-1)


def windowed_gqa_sink(q, k, v, sink):
    b, s, hq, dh = q.shape
    hkv = k.shape[2]
    g = hq // hkv
    nb = s // BLOCK
    pad = ((0, 0), (BLOCK, BLOCK), (0, 0), (0, 0))
    kp = jnp.pad(k, pad)
    vp = jnp.pad(v, pad)
    qg = q.reshape(b, s, hkv, g, dh)
    sk = sink.astype(jnp.float32).reshape(1, hkv, g, 1)
    scale = dh ** -0.5

    def block(i):
        start = i * BLOCK
        qb = lax.dynamic_slice_in_dim(qg, start, BLOCK, axis=1)
        kb = lax.dynamic_slice_in_dim(kp, start, 3 * BLOCK, axis=1)
        vb = lax.dynamic_slice_in_dim(vp, start, 3 * BLOCK, axis=1)
        qpos = start + jnp.arange(BLOCK)
        kpos = start - BLOCK + jnp.arange(3 * BLOCK)
        valid = (jnp.abs(kpos[None, :] - qpos[:, None]) <= A_WINDOW) & ((kpos >= 0) & (kpos < s))[None, :]
        sc = jnp.einsum('bqkgd,bskd->bkgqs', qb, kb).astype(jnp.float32) * scale
        sc = jnp.where(valid, sc, NEG)
        m = jnp.maximum(sc.max(-1), sk)
        p = jnp.exp(sc - m[..., None])
        den = p.sum(-1) + jnp.exp(sk - m)
        o = jnp.einsum('bkgqs,bskd->bqkgd', p, vb.astype(jnp.float32))
        o = o / den.transpose(0, 3, 1, 2)[..., None]
        return o.reshape(b, BLOCK, hq * dh)

    out = lax.map(block, jnp.arange(nb))
    return out.transpose(1, 0, 2, 3).reshape(b, s, hq * dh)


def dilated_mixture(q, k, v):
    b, s, ng, hg, dh = q.shape
    nb = s // BLOCK
    scale = dh ** -0.5
    qs = [q[:, :, gi] for gi in range(ng)]
    ks = [k[:, :, gi] for gi in range(ng)]
    vs = [v[:, :, gi] for gi in range(ng)]

    def block(i):
        start = i * BLOCK
        qpos = start + jnp.arange(BLOCK)
        outs, maxs, dens = [], [], []
        for gi, (w, d) in enumerate(B_GROUPS):
            n_side = (w // 2) // d
            offs = jnp.arange(-n_side, n_side + 1) * d
            idx = qpos[:, None] + offs[None, :]
            valid = (idx >= 0) & (idx < s)
            idx_c = jnp.clip(idx, 0, s - 1)
            qb = lax.dynamic_slice_in_dim(qs[gi], start, BLOCK, axis=1)
            kb = jnp.take(ks[gi], idx_c, axis=1)
            vb = jnp.take(vs[gi], idx_c, axis=1)
            sc = jnp.einsum('bqhd,bqjhd->bhqj', qb, kb).astype(jnp.float32) * scale
            sc = jnp.where(valid[None, None], sc, NEG)
            m = sc.max(-1)
            p = jnp.exp(sc - m[..., None])
            l = p.sum(-1)
            o = jnp.einsum('bhqj,bqjhd->bqhd', p, vb.astype(jnp.float32)) / l.transpose(0, 2, 1)[..., None]
            outs.append(o)
            maxs.append(m)
            dens.append(l)
        m_all = jnp.stack(maxs)
        l_all = jnp.stack(dens)
        wts = l_all * jnp.exp(m_all - m_all.max(0, keepdims=True))
        wts = wts / wts.sum(0, keepdims=True)
        o = (wts.transpose(0, 1, 3, 2)[..., None] * jnp.stack(outs)).sum(0)
        return o.reshape(b, BLOCK, hg * dh)

    out = lax.map(block, jnp.arange(nb))
    return out.transpose(1, 0, 2, 3).reshape(b, s, hg * dh)


def setup_inputs(seed: int = 0) -> dict:
    key = jax.random.key(seed)
    ks = jax.random.split(key, 16)
    f32 = jnp.float32
    n = lambda k, shape, sc: jax.random.normal(k, shape, f32) * sc
    x = jax.random.normal(ks[0], (BATCH, SEQ, D_MODEL), f32)
    w_in = n(ks[1], (DEPTH, D_MODEL, IN_W), D_MODEL ** -0.5)
    col_scale = np.ones((IN_W,), np.float32)
    col_scale[SPLITS[1]:SPLITS[2]] = DN_BETA
    col_scale[SPLITS[4]:] = DN_BETA
    w_in = w_in * jnp.asarray(col_scale)
    a_sink = n(ks[2], (DEPTH, A_Q_HEADS), 0.5)
    w_gate = n(ks[3], (DEPTH, D_MODEL, N_BRANCH * D_MODEL), D_MODEL ** -0.5)
    b_gate = n(ks[4], (DEPTH, N_BRANCH * D_MODEL), 0.1)
    w_br_a = n(ks[5], (DEPTH, A_OUT_W, D_MODEL), A_OUT_W ** -0.5)
    w_br_b = n(ks[6], (DEPTH, B_OUT_W, D_MODEL), B_OUT_W ** -0.5)
    w_out = n(ks[7], (DEPTH, D_MODEL, D_MODEL), DN_BETA * D_MODEL ** -0.5)
    ln1_g = 1.0 + n(ks[8], (DEPTH, D_MODEL), 0.02)
    ln1_b = n(ks[9], (DEPTH, D_MODEL), 0.02)
    w_ff_gate = n(ks[10], (DEPTH, D_MODEL, D_FF), D_MODEL ** -0.5)
    w_ff_up = n(ks[11], (DEPTH, D_MODEL, D_FF), D_MODEL ** -0.5)
    w_ff_down = n(ks[12], (DEPTH, D_FF, D_MODEL), DN_BETA * D_FF ** -0.5)
    ln2_g = 1.0 + n(ks[13], (DEPTH, D_MODEL), 0.02)
    ln2_b = n(ks[14], (DEPTH, D_MODEL), 0.02)
    return {"x": x, "w_in": w_in, "a_sink": a_sink, "w_gate": w_gate, "b_gate": b_gate,
            "w_br_a": w_br_a, "w_br_b": w_br_b, "w_out": w_out, "ln1_g": ln1_g, "ln1_b": ln1_b,
            "w_ff_gate": w_ff_gate, "w_ff_up": w_ff_up, "w_ff_down": w_ff_down,
            "ln2_g": ln2_g, "ln2_b": ln2_b}


def reference(x, w_in, a_sink, w_gate, b_gate, w_br_a, w_br_b, w_out, ln1_g, ln1_b,
              w_ff_gate, w_ff_up, w_ff_down, ln2_g, ln2_b):
    b, s, _ = x.shape
    pos = jnp.arange(s)
    h = x
    for l in range(DEPTH):
        proj = h @ w_in[l]
        qa, ka, va, qb, kb, vb = jnp.split(proj, SPLITS, axis=-1)
        qa = rope_partial(qa.reshape(b, s, A_Q_HEADS, HEAD_DIM), pos)
        ka = rope_partial(ka.reshape(b, s, A_KV_HEADS, HEAD_DIM), pos)
        va = va.reshape(b, s, A_KV_HEADS, HEAD_DIM)
        qb = rope_partial(qb.reshape(b, s, B_HEADS, HEAD_DIM), pos).reshape(b, s, B_NG, B_HEADS_PER_GROUP, HEAD_DIM)
        kb = rope_partial(kb.reshape(b, s, B_HEADS, HEAD_DIM), pos).reshape(b, s, B_NG, B_HEADS_PER_GROUP, HEAD_DIM)
        vb = vb.reshape(b, s, B_NG, B_HEADS_PER_GROUP, HEAD_DIM)
        o_a = windowed_gqa_sink(qa, ka, va, a_sink[l]).astype(h.dtype)
        o_b = dilated_mixture(qb, kb, vb).astype(h.dtype)
        gates = jax.nn.sigmoid(h @ w_gate[l] + b_gate[l])
        g_a, g_b = jnp.split(gates, N_BRANCH, axis=-1)
        mixed = g_a * (o_a @ w_br_a[l]) + g_b * (o_b @ w_br_b[l])
        y = mixed @ w_out[l]
        h = layer_norm(DN_ALPHA * h + y, ln1_g[l], ln1_b[l])
        f = (jax.nn.silu(h @ w_ff_gate[l]) * (h @ w_ff_up[l])) @ w_ff_down[l]
        h = layer_norm(DN_ALPHA * h + f, ln2_g[l], ln2_b[l])
    return h
```

```cpp
#include <hip/hip_runtime.h>
#include <cstdio>
#include <cstdint>

#ifndef MK_N_LAUNCHES
#define MK_N_LAUNCHES 10
#endif

constexpr int BATCH = 8, SEQ = 8192, DM = 1024, MTOK = BATCH * SEQ;
constexpr int IN_W = 3840, DFF = 2816;
constexpr float LN_EPS = 1e-5f, DN_ALPHA = 1.189207115002721f;
constexpr float QSCALE = 0.18033688011112042f;
constexpr float LOG2E = 1.4426950408889634f;

__host__ __device__ __forceinline__ int img_off(int rho, int c) { return (rho >> 1) * 256 + (((((rho & 1) << 3) | c) ^ ((rho >> 1) & 7)) << 4); }

namespace pg8 {
#define PG8_LAS __attribute__((address_space(3)))
typedef unsigned short bf16_t;
typedef short bf16x8 __attribute__((ext_vector_type(8)));
typedef float f32x4 __attribute__((ext_vector_type(4)));
typedef unsigned u32x4 __attribute__((ext_vector_type(4)));
typedef unsigned u32x2 __attribute__((ext_vector_type(2)));
constexpr int BM = 256, BK = 64, HALF = 128, HTB = HALF * BK * 2  , STAGE_BYTES = 8 * HTB, NXCD = 8, WGM = 8;

__host__ __device__ __forceinline__ int lds_byte(int r, int c) { const int st = (r >> 4) * 2 + (c >> 5), rr = r & 15, cc = c & 31, ob = rr * 64 + cc * 2; return st * 1024 + (ob ^ (((ob >> 9) & 1) << 5)); }
__host__ __device__ __forceinline__ void stage_rc(int b, int& R, int& C) { const int st = b / 1024, sb = b % 1024, swz = sb ^ (((sb >> 9) & 1) << 5); R = (st >> 1) * 16 + swz / 64; C = (st & 1) * 32 + (swz % 64) / 2; }
__host__ __device__ __forceinline__ int perm32(int rho) { const int n = rho >> 4, i = rho & 15; return 8 * (i >> 2) + 4 * n + (i & 3); }

struct Unit { int pm, pn; };
struct Gemm { const bf16_t* A; const bf16_t* Bt; int M, N, K; int bmul; };

__device__ __forceinline__ size_t b_unit_off(const Gemm& g, int pn) {
    if (g.bmul == 1) return (size_t)pn * 256 * (size_t)g.K * 2;
    const int P0 = pn * 256, b = P0 >> 13, p = P0 & 8191, L = 8192 / g.bmul, seq = p / L, pos = p % L;
    return (size_t)(b * 8192 + pos * g.bmul + seq) * (size_t)g.K * 2;
}

struct StaticOrder {
    int nM, nN, nwg, G, c;
    __host__ __device__ void init(int M, int N, int G_, int c_) { nM = M / BM; nN = N / BM; nwg = nM * nN; G = G_; c = c_; }
    __host__ __device__ bool next(int i, Unit& u) const {
        const long L = (long)i * G + c; if (L >= nwg) return false;
        int wgid = (int)L; { const int q = nwg / NXCD, r = nwg % NXCD, xcd = wgid % NXCD, off = wgid / NXCD; wgid = (xcd < r ? xcd * (q + 1) : r * (q + 1) + (xcd - r) * q) + off; }
        const int nig = WGM * nN, gid = wgid / nig, fm = gid * WGM, gsz = (nM - fm) < WGM ? (nM - fm) : WGM;
        u.pm = fm + ((wgid % nig) % gsz); u.pn = (wgid % nig) / gsz; return true;
    }
    __device__ __forceinline__ void a_ready(const Unit&) const {}
    __device__ __forceinline__ void done(const Unit&) const {}
};

typedef float f32x2_t __attribute__((ext_vector_type(2))); typedef __bf16 bf16x2_t __attribute__((ext_vector_type(2)));
__device__ __forceinline__ unsigned cvt_pk_bf16(float lo, float hi) { f32x2_t v = {lo, hi}; bf16x2_t b = __builtin_convertvector(v, bf16x2_t); return __builtin_bit_cast(unsigned, b); }
__device__ __forceinline__ float bf_lo(unsigned w) { return __uint_as_float(w << 16); }
__device__ __forceinline__ float bf_hi(unsigned w) { return __uint_as_float(w & 0xffff0000u); }
__device__ __forceinline__ float sigmoidf_(float z) { return __builtin_amdgcn_rcpf(1.0f + __builtin_amdgcn_exp2f(-z * LOG2E)); }
__device__ __forceinline__ u32x4 pack8(const f32x4 a, const f32x4 b) { u32x4 w; w.x = cvt_pk_bf16(a[0], a[1]); w.y = cvt_pk_bf16(a[2], a[3]); w.z = cvt_pk_bf16(b[0], b[1]); w.w = cvt_pk_bf16(b[2], b[3]); return w; }


struct EpiProj {
    static constexpr bool PERM = true, AFTER_DRAIN = false;
    bf16_t *QA, *KA, *QB, *KB, *GT; const float* rope; const float* bgate;
    __device__ __forceinline__ void operator()(const f32x4 (&acc)[2][2][4][2], const Unit& u, int wr, int wc, int fr, int fq) const {
        const int pn = u.pn, row0 = u.pm * BM + wr * 64 + fr;
        if (pn >= 11) {
            const int col0 = (pn - 11) * 256 + wc * 32 + 8 * fq;
            f32x4 bv[2][2];
#pragma unroll
            for (int bj = 0; bj < 2; ++bj)
#pragma unroll
                for (int n = 0; n < 2; ++n) bv[bj][n] = *(const f32x4*)(bgate + col0 + bj * HALF + 4 * n);
#pragma unroll
            for (int ai = 0; ai < 2; ++ai)
#pragma unroll
                for (int m = 0; m < 4; ++m) { bf16_t* rowp = GT + (size_t)(row0 + ai * HALF + m * 16) * 2048 + col0;
#pragma unroll
                    for (int bj = 0; bj < 2; ++bj) { f32x4 v0 = acc[ai][bj][m][0] + bv[bj][0], v1 = acc[ai][bj][m][1] + bv[bj][1];
#pragma unroll
                        for (int e = 0; e < 4; ++e) { v0[e] = sigmoidf_(v0[e]); v1[e] = sigmoidf_(v1[e]); }
                        *(u32x4*)(rowp + bj * HALF) = pack8(v0, v1); } }
            return;
        }
        const int typ = pn < 4 ? 0 : (pn == 4 ? 1 : (pn < 8 ? 2 : 3));
        const int grp = typ == 2 ? pn - 5 : (typ == 3 ? pn - 8 : 0);
        const float sc = (typ == 0 || typ == 2) ? QSCALE : 1.0f;
        const bool rot_wave = (wc & 1) == 0, rot_lane = fq < 2;
        const float sgn = fq == 0 ? -1.0f : 1.0f;
        const int chunk = 4 * (wc & 1) + fq;
#pragma unroll
        for (int ai = 0; ai < 2; ++ai)
#pragma unroll
            for (int m = 0; m < 4; ++m) {
                const int tg = row0 + ai * HALF + m * 16, b = tg >> 13, t = tg & 8191;
                f32x4 c0 = {1.f, 1.f, 1.f, 1.f}, c1 = c0, s0 = {0.f, 0.f, 0.f, 0.f}, s1 = s0;
                if (rot_wave && rot_lane) { const f32x4* rp = (const f32x4*)(rope + (size_t)t * 16); c0 = rp[0]; c1 = rp[1]; s0 = rp[2] * sgn; s1 = rp[3] * sgn; }
                const int p = grp == 0 ? t : (grp == 1 ? ((t & 3) * 2048 + (t >> 2)) : ((t & 15) * 512 + (t >> 4)));
#pragma unroll
                for (int bj = 0; bj < 2; ++bj) {
                    f32x4 v0 = acc[ai][bj][m][0], v1 = acc[ai][bj][m][1];
                    if (rot_wave) {
                        f32x4 q0, q1;
#pragma unroll
                        for (int e = 0; e < 4; ++e) { q0[e] = __shfl_xor(v0[e], 16); q1[e] = __shfl_xor(v1[e], 16); }
                        v0 = v0 * c0 + q0 * s0; v1 = v1 * c1 + q1 * s1;
                    }
                    v0 = v0 * sc; v1 = v1 * sc;
                    const int cl = bj * HALF + wc * 32 + 8 * fq, hh = 2 * bj + (wc >> 1);
                    bf16_t* dst;
                    if (typ == 0)      dst = QA + (size_t)tg * 1024 + pn * 256 + cl;
                    else if (typ == 1) dst = KA + ((size_t)((b * 4 + hh) * 128 + (t >> 6))) * 4096 + (img_off(t & 63, chunk) >> 1);
                    else if (typ == 2) dst = QB + (size_t)(b * 8192 + p) * 768 + grp * 256 + cl;
                    else               dst = KB + ((size_t)(((b * 3 + grp) * 4 + hh) * 128 + (p >> 6))) * 4096 + (img_off(p & 63, chunk) >> 1);
                    *(u32x4*)dst = pack8(v0, v1);
                }
            }
    }
};
struct EpiVT {
    static constexpr bool PERM = true, AFTER_DRAIN = false;
    bf16_t* dst[2]; int nhb[2], hoff[2];
    __device__ __forceinline__ void operator()(const f32x4 (&acc)[2][2][4][2], const Unit& u, int wr, int wc, int fr, int fq) const {
        bf16_t* base = u.pm == 0 ? dst[0] : dst[1]; const int nh = u.pm == 0 ? nhb[0] : nhb[1], ho = u.pm == 0 ? hoff[0] : hoff[1];
        const int P0 = u.pn * BM, b = P0 >> 13, j0 = (P0 & 8191) >> 6, chunk = 4 * (wc & 1) + fq;
#pragma unroll
        for (int ai = 0; ai < 2; ++ai)
#pragma unroll
            for (int m = 0; m < 4; ++m) { const int hh = 2 * ai + wr, d = m * 16 + fr;
#pragma unroll
                for (int bj = 0; bj < 2; ++bj) { const int j = j0 + 2 * bj + (wc >> 1);
                    bf16_t* p = base + ((size_t)((b * nh + ho + hh) * 128 + j)) * 4096 + (img_off(d, chunk) >> 1);
                    *(u32x4*)p = pack8(acc[ai][bj][m][0], acc[ai][bj][m][1]); } }
    }
};
template <bool FIRST> struct EpiGate {
    static constexpr bool PERM = true, AFTER_DRAIN = false;
    bf16_t* MX; const bf16_t* GT; int goff;
    __device__ __forceinline__ void operator()(const f32x4 (&acc)[2][2][4][2], const Unit& u, int wr, int wc, int fr, int fq) const {
        const int row0 = u.pm * BM + wr * 64 + fr, col0 = u.pn * BM + wc * 32 + 8 * fq;
#pragma unroll
        for (int ai = 0; ai < 2; ++ai)
#pragma unroll
            for (int m = 0; m < 4; ++m) { const size_t r = (size_t)(row0 + ai * HALF + m * 16);
#pragma unroll
                for (int bj = 0; bj < 2; ++bj) {
                    const u32x4 gw = *(const u32x4*)(GT + r * 2048 + goff + col0 + bj * HALF);
                    f32x4 v0 = acc[ai][bj][m][0], v1 = acc[ai][bj][m][1];
                    v0[0] *= bf_lo(gw.x); v0[1] *= bf_hi(gw.x); v0[2] *= bf_lo(gw.y); v0[3] *= bf_hi(gw.y);
                    v1[0] *= bf_lo(gw.z); v1[1] *= bf_hi(gw.z); v1[2] *= bf_lo(gw.w); v1[3] *= bf_hi(gw.w);
                    bf16_t* dp = MX + r * 1024 + col0 + bj * HALF;
                    if (!FIRST) { const u32x4 ow = *(const u32x4*)dp;
                        v0[0] += bf_lo(ow.x); v0[1] += bf_hi(ow.x); v0[2] += bf_lo(ow.y); v0[3] += bf_hi(ow.y);
                        v1[0] += bf_lo(ow.z); v1[1] += bf_hi(ow.z); v1[2] += bf_lo(ow.w); v1[3] += bf_hi(ow.w); }
                    *(u32x4*)dp = pack8(v0, v1); } }
    }
};
struct EpiRes {
    static constexpr bool PERM = false, AFTER_DRAIN = false;
    const float* base; float* out; int noy;
    __device__ __forceinline__ void operator()(const f32x4 (&acc)[2][2][4][2], const Unit& u, int wr, int wc, int fr, int fq) const {
        const int row0 = u.pm * BM + wr * 64 + fr, col0 = u.pn * BM + wc * 32 + 4 * fq;
#pragma unroll
        for (int ai = 0; ai < 2; ++ai)
#pragma unroll
            for (int m = 0; m < 4; ++m) { const size_t off = (size_t)(row0 + ai * HALF + m * 16) * 1024 + col0;
#pragma unroll
                for (int bj = 0; bj < 2; ++bj)
#pragma unroll
                    for (int n = 0; n < 2; ++n) { const f32x4 bs = *(const f32x4*)(base + off + bj * HALF + n * 16);
#ifdef DBG_NOY
                        *(f32x4*)(out + off + bj * HALF + n * 16) = bs * DN_ALPHA + (noy ? acc[ai][bj][m][n] * 0.0f : acc[ai][bj][m][n]); } }
#else
                        *(f32x4*)(out + off + bj * HALF + n * 16) = bs * DN_ALPHA + acc[ai][bj][m][n]; } }
#endif
    }
};
struct EpiSwiGLU {
    static constexpr bool PERM = true, AFTER_DRAIN = false;
    bf16_t* T;
    __device__ __forceinline__ void operator()(const f32x4 (&acc)[2][2][4][2], const Unit& u, int wr, int wc, int fr, int fq) const {
        const int row0 = u.pm * BM + wr * 64 + fr, col0 = u.pn * HALF + wc * 32 + 8 * fq;
#pragma unroll
        for (int ai = 0; ai < 2; ++ai)
#pragma unroll
            for (int m = 0; m < 4; ++m) { f32x4 v0, v1;
#pragma unroll
                for (int e = 0; e < 4; ++e) { const float g0 = acc[ai][0][m][0][e], g1 = acc[ai][0][m][1][e];
                    v0[e] = g0 * sigmoidf_(g0) * acc[ai][1][m][0][e]; v1[e] = g1 * sigmoidf_(g1) * acc[ai][1][m][1][e]; }
                *(u32x4*)(T + (size_t)(row0 + ai * HALF + m * 16) * DFF + col0) = pack8(v0, v1); }
    }
};

template <class Epi, class Sched, bool ALIGN_EPI = false, bool SP2 = false>
__device__ __forceinline__ void gemm_phase(PG8_LAS unsigned char* lds, const Gemm g, const Sched& S, const Epi& E) {
    int tid_ = threadIdx.x; asm volatile("" : "+v"(tid_));
    const int tid = tid_, wid = __builtin_amdgcn_readfirstlane(tid >> 6), lane = tid & 63, wr = wid >> 2, wc = wid & 3, fr = lane & 15, fq = lane >> 4;
    const int K = g.K, nt = K / BK;
    unsigned voffA[2], voffB[2];
#pragma unroll
    for (int i = 0; i < 2; ++i) { int R, C; stage_rc(tid * 16 + i * 8192, R, C); const int Rb = Epi::PERM ? ((R & ~31) + perm32(R & 31)) : R;
        voffA[i] = (unsigned)(R * K + C) * 2u; voffB[i] = (unsigned)(Rb * K * g.bmul + C) * 2u; }
    const size_t kstep = (size_t)(BK * 2);
    const size_t hstep = (size_t)HALF * K * 2;
    const size_t tstep = 2 * hstep;   const size_t hstepB = hstep * (size_t)g.bmul;
    const unsigned ldsw = (unsigned)wid * 1024u;
    const int aoff = lds_byte(wr * 64 + fr, fq * 8), boff = lds_byte(wc * 32 + fr, fq * 8);
#define PG8_SA(b, h) (((b) * 2 + (h)) * HTB)
#define PG8_SB(b, h) ((4 + (b) * 2 + (h)) * HTB)
#define PG8_STAGE(bufoff, gbase, voff) do { _Pragma("unroll") for (int _i = 0; _i < 2; ++_i) \
        __builtin_amdgcn_global_load_lds((const unsigned*)((const char*)(gbase) + (voff)[_i]), (PG8_LAS unsigned*)(lds + (bufoff) + ldsw + _i * 8192), 16, 0, 0); } while (0)
#define PG8_LDA(dst, b, h) do { _Pragma("unroll") for (int m = 0; m < 4; ++m) _Pragma("unroll") for (int k = 0; k < 2; ++k) dst[m][k] = *(const PG8_LAS bf16x8*)(lds + PG8_SA(b, h) + aoff + m * 2048 + k * 1024); } while (0)
#define PG8_LDB(dst, b, h) do { _Pragma("unroll") for (int n = 0; n < 2; ++n) _Pragma("unroll") for (int k = 0; k < 2; ++k) dst[n][k] = *(const PG8_LAS bf16x8*)(lds + PG8_SB(b, h) + boff + n * 2048 + k * 1024); } while (0)
#define PG8_MMA(ai, bj, At, Bt) do { __builtin_amdgcn_s_setprio(1); _Pragma("unroll") for (int m = 0; m < 4; ++m) _Pragma("unroll") for (int n = 0; n < 2; ++n) _Pragma("unroll") for (int k = 0; k < 2; ++k) \
        acc[ai][bj][m][n] = __builtin_amdgcn_mfma_f32_16x16x32_bf16(Bt[n][k], At[m][k], acc[ai][bj][m][n], 0, 0, 0); __builtin_amdgcn_s_setprio(0); } while (0)
#define PG8_WAIT_V(n) asm volatile("s_waitcnt vmcnt(" #n ")" ::: "memory")
#define PG8_WAIT_L(n) asm volatile("s_waitcnt lgkmcnt(" #n ")" ::: "memory")
#define PG8_BAR __builtin_amdgcn_s_barrier()
#define PG8_SCHED __builtin_amdgcn_sched_barrier(0)
    Unit cur, nxt; int ui = 0;
    if (!S.next(0, cur)) return;
    f32x4 acc[2][2][4][2];
#pragma unroll
    for (int a = 0; a < 2; ++a)
#pragma unroll
        for (int b = 0; b < 2; ++b)
#pragma unroll
            for (int m = 0; m < 4; ++m)
#pragma unroll
                for (int n = 0; n < 2; ++n) acc[a][b][m][n] = (f32x4){0.f, 0.f, 0.f, 0.f};
    bf16x8 At[4][2], B0[2][2], B1[2][2];
    const char* cA = (const char*)g.A + (size_t)cur.pm * tstep; const char* cB = (const char*)g.Bt + b_unit_off(g, cur.pn);
    S.a_ready(cur);
    if constexpr (SP2) {
        PG8_STAGE(PG8_SB(0, 0), cB, voffB); PG8_STAGE(PG8_SB(0, 1), cB + hstepB, voffB); PG8_STAGE(PG8_SA(0, 0), cA, voffA); PG8_STAGE(PG8_SA(0, 1), cA + hstep, voffA);
        if (wr == 1) PG8_BAR;
        PG8_WAIT_V(2); PG8_BAR;
        PG8_STAGE(PG8_SB(1, 0), cB + kstep, voffB); PG8_STAGE(PG8_SA(1, 0), cA + kstep, voffA); PG8_STAGE(PG8_SB(1, 1), cB + hstepB + kstep, voffB);
        PG8_WAIT_V(6); PG8_BAR;
    } else {
        PG8_STAGE(PG8_SB(0, 0), cB, voffB); PG8_STAGE(PG8_SA(0, 0), cA, voffA); PG8_STAGE(PG8_SB(0, 1), cB + hstepB, voffB); PG8_STAGE(PG8_SA(0, 1), cA + hstep, voffA);
        if (wr == 1) PG8_BAR;
        PG8_WAIT_V(4); PG8_BAR;
        PG8_STAGE(PG8_SB(1, 0), cB + kstep, voffB); PG8_STAGE(PG8_SA(1, 0), cA + kstep, voffA); PG8_STAGE(PG8_SB(1, 1), cB + hstepB + kstep, voffB);
        PG8_WAIT_V(6); PG8_BAR;
    }
    for (;;) {
        const bool has_next = S.next(ui + 1, nxt);
        const char* nA = has_next ? (const char*)g.A + (size_t)nxt.pm * tstep : cA; const char* nB = has_next ? (const char*)g.Bt + b_unit_off(g, nxt.pn) : cB;
        for (int t = 0; t < nt; t += 2) {
            const bool last = (t == nt - 2);
            const char* a1 = cA + (size_t)(t + 1) * kstep;
            const char* a2 = last ? nA : cA + (size_t)(t + 2) * kstep; const char* b2 = last ? nB : cB + (size_t)(t + 2) * kstep;
            const char* a3 = a2 + kstep; const char* b3 = b2 + kstep;
            if (last && has_next) S.a_ready(nxt);
            if constexpr (SP2) {
            PG8_LDB(B0, 0, 0); PG8_LDB(B1, 0, 1); PG8_SCHED; PG8_LDA(At, 0, 0); PG8_STAGE(PG8_SA(1, 1), a1 + hstep, voffA);
            PG8_WAIT_V(8); PG8_WAIT_L(0); PG8_BAR; PG8_MMA(0, 0, At, B0); PG8_MMA(0, 1, At, B1); PG8_BAR; PG8_SCHED;
            PG8_LDA(At, 0, 1); PG8_STAGE(PG8_SB(0, 0), b2, voffB); PG8_STAGE(PG8_SB(0, 1), b2 + hstepB, voffB); PG8_STAGE(PG8_SA(0, 0), a2, voffA);
            PG8_WAIT_V(8); PG8_WAIT_L(0); PG8_BAR; PG8_MMA(1, 0, At, B0); PG8_MMA(1, 1, At, B1); PG8_BAR; PG8_SCHED;
            PG8_LDB(B0, 1, 0); PG8_LDB(B1, 1, 1); PG8_SCHED; PG8_LDA(At, 1, 0); PG8_STAGE(PG8_SA(0, 1), a2 + hstep, voffA);
            PG8_WAIT_V(8); PG8_WAIT_L(0); PG8_BAR; PG8_MMA(0, 0, At, B0); PG8_MMA(0, 1, At, B1); PG8_BAR; PG8_SCHED;
            PG8_LDA(At, 1, 1); PG8_STAGE(PG8_SB(1, 0), b3, voffB); PG8_STAGE(PG8_SB(1, 1), b3 + hstepB, voffB); PG8_STAGE(PG8_SA(1, 0), a3, voffA);
            PG8_WAIT_V(8); PG8_WAIT_L(0); PG8_BAR; PG8_MMA(1, 0, At, B0); PG8_MMA(1, 1, At, B1); PG8_BAR; PG8_SCHED;
            } else {
            PG8_LDB(B0, 0, 0); PG8_SCHED; PG8_LDA(At, 0, 0); PG8_STAGE(PG8_SA(1, 1), a1 + hstep, voffA);
            PG8_WAIT_L(8); PG8_BAR; PG8_WAIT_L(0); PG8_MMA(0, 0, At, B0); PG8_BAR; PG8_SCHED;
            PG8_LDB(B1, 0, 1); PG8_STAGE(PG8_SB(0, 0), b2, voffB);
            PG8_BAR; PG8_WAIT_L(0); PG8_MMA(0, 1, At, B1); PG8_BAR;
            PG8_LDA(At, 0, 1); PG8_STAGE(PG8_SA(0, 0), a2, voffA);
            PG8_BAR; PG8_WAIT_L(0); PG8_MMA(1, 0, At, B0); PG8_BAR; PG8_SCHED;
            PG8_STAGE(PG8_SB(0, 1), b2 + hstepB, voffB);
            PG8_WAIT_V(6); PG8_BAR; PG8_MMA(1, 1, At, B1); PG8_BAR;
            PG8_LDB(B0, 1, 0); PG8_SCHED; PG8_LDA(At, 1, 0); PG8_STAGE(PG8_SA(0, 1), a2 + hstep, voffA);
            PG8_WAIT_L(8); PG8_BAR; PG8_WAIT_L(0); PG8_MMA(0, 0, At, B0); PG8_BAR; PG8_SCHED;
            PG8_LDB(B1, 1, 1); PG8_STAGE(PG8_SB(1, 0), b3, voffB);
            PG8_BAR; PG8_WAIT_L(0); PG8_MMA(0, 1, At, B1); PG8_BAR;
            PG8_LDA(At, 1, 1); PG8_STAGE(PG8_SA(1, 0), a3, voffA);
            PG8_BAR; PG8_WAIT_L(0); PG8_MMA(1, 0, At, B0); PG8_BAR; PG8_SCHED;
            PG8_STAGE(PG8_SB(1, 1), b3 + hstepB, voffB);
            PG8_WAIT_V(6); PG8_BAR; PG8_MMA(1, 1, At, B1); PG8_BAR;
            }
        }
        if constexpr (ALIGN_EPI) { if (wr == 0) PG8_BAR; }
        if constexpr (!Epi::AFTER_DRAIN) { E(acc, cur, wr, wc, fr, fq); S.done(cur); }
        if (!has_next) break;
#pragma unroll
        for (int a = 0; a < 2; ++a)
#pragma unroll
            for (int b = 0; b < 2; ++b)
#pragma unroll
                for (int m = 0; m < 4; ++m)
#pragma unroll
                    for (int n = 0; n < 2; ++n) acc[a][b][m][n] = (f32x4){0.f, 0.f, 0.f, 0.f};
        cur = nxt; cA = nA; cB = nB; ++ui;
        if constexpr (ALIGN_EPI) { if (wr == 1) PG8_BAR; }
    }
    PG8_WAIT_V(0);
    if constexpr (!ALIGN_EPI) { if (wr == 0) PG8_BAR; }
    PG8_BAR;
    if constexpr (Epi::AFTER_DRAIN) { E.fused(acc, cur, wr, wc, fr, fq, lds, wid, lane); S.done(cur); }
#undef PG8_SA
#undef PG8_SB
#undef PG8_STAGE
#undef PG8_LDA
#undef PG8_LDB
#undef PG8_MMA
#undef PG8_WAIT_V
#undef PG8_WAIT_L
#undef PG8_BAR
#undef PG8_SCHED
}
}

namespace att {
typedef unsigned short bf16_t;
typedef short bf16x8 __attribute__((ext_vector_type(8)));
typedef float f32x16 __attribute__((ext_vector_type(16)));
typedef unsigned u32x4 __attribute__((ext_vector_type(4)));
typedef unsigned u32x2 __attribute__((ext_vector_type(2)));
typedef float f32x2_t __attribute__((ext_vector_type(2))); typedef __bf16 bf16x2_t __attribute__((ext_vector_type(2)));
__device__ __forceinline__ unsigned cvtpk(float lo, float hi) { f32x2_t v = {lo, hi}; bf16x2_t b = __builtin_convertvector(v, bf16x2_t); return __builtin_bit_cast(unsigned, b); }
__device__ __forceinline__ float swap_max(float v) { auto rr = __builtin_amdgcn_permlane32_swap(__float_as_uint(v), __float_as_uint(v), false, false); return fmaxf(__uint_as_float(rr[0]), __uint_as_float(rr[1])); }
__device__ __forceinline__ float swap_sum(float v) { auto rr = __builtin_amdgcn_permlane32_swap(__float_as_uint(v), __float_as_uint(v), false, false); return __uint_as_float(rr[0]) + __uint_as_float(rr[1]); }

template <int W>
__device__ __forceinline__ void wave_attn(const bf16_t* Qrow0, int qstride, const char* Kt, const char* Vt, int ntiles, int q0, float m_init, float l_init,
                                          f32x16 (&o)[2], float& m_out, float& l_out, int lane) {
    const int r32 = lane & 31, hi = lane >> 5;
    bf16x8 qf[4];
#pragma unroll
    for (int d0 = 0; d0 < 4; ++d0) qf[d0] = *(const bf16x8*)(Qrow0 + (size_t)r32 * qstride + d0 * 16 + hi * 8);
    const int krow = (r32 & 0x13) | ((r32 & 4) << 1) | ((r32 & 8) >> 1);
    int koff[4], voff[4];
#pragma unroll
    for (int i = 0; i < 4; ++i) { koff[i] = img_off(krow, 2 * i + hi); voff[i] = img_off(r32, 2 * i + hi); }
    o[0] = f32x16{}; o[1] = f32x16{};
    float m = m_init, l = hi == 0 ? l_init : 0.0f;
    int jlo = (q0 - W) >> 6; if (jlo < 0) jlo = 0;
    int jhi = (q0 + 31 + W) >> 6; if (jhi > ntiles - 1) jhi = ntiles - 1;
    for (int j = jlo; j <= jhi; ++j) {
        const char* kt = Kt + (size_t)j * 8192; const char* vt = Vt + (size_t)j * 8192;
        bf16x8 k0[4], k1[4];
#pragma unroll
        for (int d0 = 0; d0 < 4; ++d0) { k0[d0] = *(const bf16x8*)(kt + koff[d0]); k1[d0] = *(const bf16x8*)(kt + koff[d0] + 4096); }
        bf16x8 vf[2][4];
#pragma unroll
        for (int db = 0; db < 2; ++db)
#pragma unroll
            for (int s = 0; s < 4; ++s) vf[db][s] = *(const bf16x8*)(vt + voff[s] + db * 4096);
        f32x16 p0 = f32x16{}, p1 = f32x16{};
#pragma unroll
        for (int d0 = 0; d0 < 4; ++d0) { p0 = __builtin_amdgcn_mfma_f32_32x32x16_bf16(k0[d0], qf[d0], p0, 0, 0, 0); p1 = __builtin_amdgcn_mfma_f32_32x32x16_bf16(k1[d0], qf[d0], p1, 0, 0, 0); }
        const bool full = (64 * j >= q0 + 31 - W) && (64 * j + 63 <= q0 + W);
        if (!full) {
            const int dlt = 64 * j + 8 * hi - (q0 + r32);
#pragma unroll
            for (int r = 0; r < 16; ++r) { const int dk = dlt + 16 * (r >> 3) + (r & 7);
                if (dk < -W || dk > W) p0[r] = -INFINITY;
                if (dk + 32 < -W || dk + 32 > W) p1[r] = -INFINITY; }
        }
        float mx = fmaxf(p0[0], p1[0]);
#pragma unroll
        for (int r = 1; r < 16; ++r) mx = fmaxf(mx, fmaxf(p0[r], p1[r]));
        mx = swap_max(mx);
        const float mn = fmaxf(m, mx);
        const float alpha = __builtin_amdgcn_exp2f(m - mn);
        m = mn; l *= alpha;
#pragma unroll
        for (int r = 0; r < 16; ++r) { o[0][r] *= alpha; o[1][r] *= alpha; }
        float s = 0.f;
#pragma unroll
        for (int r = 0; r < 16; ++r) { p0[r] = __builtin_amdgcn_exp2f(p0[r] - mn); p1[r] = __builtin_amdgcn_exp2f(p1[r] - mn); s += p0[r] + p1[r]; }
        l += s;
        u32x4 w0 = {cvtpk(p0[0], p0[1]), cvtpk(p0[2], p0[3]), cvtpk(p0[4], p0[5]), cvtpk(p0[6], p0[7])};
        u32x4 w1 = {cvtpk(p0[8], p0[9]), cvtpk(p0[10], p0[11]), cvtpk(p0[12], p0[13]), cvtpk(p0[14], p0[15])};
        u32x4 w2 = {cvtpk(p1[0], p1[1]), cvtpk(p1[2], p1[3]), cvtpk(p1[4], p1[5]), cvtpk(p1[6], p1[7])};
        u32x4 w3 = {cvtpk(p1[8], p1[9]), cvtpk(p1[10], p1[11]), cvtpk(p1[12], p1[13]), cvtpk(p1[14], p1[15])};
        const bf16x8 b0 = __builtin_bit_cast(bf16x8, w0), b1 = __builtin_bit_cast(bf16x8, w1), b2 = __builtin_bit_cast(bf16x8, w2), b3 = __builtin_bit_cast(bf16x8, w3);
#pragma unroll
        for (int db = 0; db < 2; ++db) {
            o[db] = __builtin_amdgcn_mfma_f32_32x32x16_bf16(vf[db][0], b0, o[db], 0, 0, 0);
            o[db] = __builtin_amdgcn_mfma_f32_32x32x16_bf16(vf[db][1], b1, o[db], 0, 0, 0);
            o[db] = __builtin_amdgcn_mfma_f32_32x32x16_bf16(vf[db][2], b2, o[db], 0, 0, 0);
            o[db] = __builtin_amdgcn_mfma_f32_32x32x16_bf16(vf[db][3], b3, o[db], 0, 0, 0);
        }
    }
    m_out = m; l_out = swap_sum(l);
}
__device__ __forceinline__ void store_o(bf16_t* orow, const f32x16 (&o)[2], float inv, int hi) {
#pragma unroll
    for (int db = 0; db < 2; ++db)
#pragma unroll
        for (int k4 = 0; k4 < 4; ++k4) { u32x2 w; w.x = cvtpk(o[db][4 * k4] * inv, o[db][4 * k4 + 1] * inv); w.y = cvtpk(o[db][4 * k4 + 2] * inv, o[db][4 * k4 + 3] * inv);
            *(u32x2*)(orow + db * 32 + k4 * 8 + hi * 4) = w; }
}
}

constexpr int NWAVES = 8;
constexpr int N_LAUNCHES = MK_N_LAUNCHES;
constexpr int PER_PHASE = 10;
static_assert(N_LAUNCHES == 1 || N_LAUNCHES == PER_PHASE, "MK_N_LAUNCHES: 1 (one launch) or 10 (one launch per phase)");

constexpr size_t MiB = 1u << 20;
constexpr size_t WS_CTL = 0, CTL_ZERO_BYTES = 1 * MiB;
constexpr size_t WS_ROPE = 1 * MiB;
constexpr size_t WS_W1 = 2 * MiB;
constexpr size_t WS_WV = 12 * MiB;
constexpr size_t WS_WA = 14 * MiB, WS_WB = 16 * MiB, WS_WO = 17 * MiB;
constexpr size_t WS_WGU = 19 * MiB;
constexpr size_t WS_WD = 30 * MiB;
constexpr size_t WS_ST = 36 * MiB;
constexpr size_t WS_XB = 64 * MiB;
constexpr size_t WS_QA = 192 * MiB;
constexpr size_t WS_KA = 320 * MiB, WS_VAT = 352 * MiB;
constexpr size_t WS_QB = 384 * MiB, WS_KB = 480 * MiB, WS_VBT = 576 * MiB;
constexpr size_t WS_GT = 672 * MiB;
constexpr size_t WS_OBG = 928 * MiB;
constexpr size_t WS_T = 192 * MiB;
constexpr size_t WS_END = 1024 * MiB;
static_assert(WS_T + (size_t)MTOK * DFF * 2 <= WS_GT && WS_OBG + (size_t)3 * MTOK * 256 * 2 <= WS_END && WS_WD + (size_t)1024 * DFF * 2 <= WS_ST, "d_ws map");
constexpr int CW_TMO = 0, CW_CODE = 1, CW_BAR = 4096;

constexpr int RING_OFF = 0, RING_BYTES = 131072;
constexpr int LDSCTL_OFF = RING_BYTES, MISC_OFF = LDSCTL_OFF + 320;
constexpr int LDS_BYTES = 147456;

#define GAS __attribute__((address_space(1)))
#define LAS __attribute__((address_space(3)))
typedef unsigned short bf16;
typedef unsigned v4u __attribute__((ext_vector_type(4)));
typedef float f32x4 __attribute__((ext_vector_type(4)));
typedef short bf16x8 __attribute__((ext_vector_type(8)));
typedef GAS unsigned gu32;
typedef GAS unsigned long long gu64;
#define RLX_AGENT __ATOMIC_RELAXED, __HIP_MEMORY_SCOPE_AGENT
#define LDS_WAIT() asm volatile("s_waitcnt lgkmcnt(0)" ::: "memory")
#define VM_WAIT() asm volatile("s_waitcnt vmcnt(0)" ::: "memory")
__device__ __forceinline__ unsigned long long rt() { return __builtin_amdgcn_s_memrealtime(); }
__device__ __forceinline__ unsigned f2bf(float f) { unsigned u = __builtin_bit_cast(unsigned, f); return (u + 0x7fffu + ((u >> 16) & 1u)) >> 16; }
__device__ __forceinline__ unsigned pk2(float lo, float hi) { return f2bf(lo) | (f2bf(hi) << 16); }

#define XB_TMO      128
#define XB_XCNT(j)  (256  + 64 * (j))
#define XB_XSUB(j)  (1280 + 64 * (j))
#define XB_XGEN(j)  (2304 + 64 * (j))
#define XB_TOP      3328
#define XB_TOPGEN   3392
#define XCD_BAR_WORDS 3456
#define XB_SPIN_CAP (1u << 18)

__device__ __forceinline__ unsigned xb_ld(unsigned* p)              { return __hip_atomic_load(p, __ATOMIC_RELAXED, __HIP_MEMORY_SCOPE_AGENT); }
__device__ __forceinline__ unsigned xb_add(unsigned* p, unsigned v) { return __hip_atomic_fetch_add(p, v, __ATOMIC_RELAXED, __HIP_MEMORY_SCOPE_AGENT); }
__device__ __forceinline__ unsigned xb_xcc_id() { return (unsigned)__builtin_amdgcn_s_getreg((3 << 11) | 20) & 0xFu; }
#define XB_SPIN(cond, bar) do { unsigned _sp = 0; while (cond) { __builtin_amdgcn_s_sleep(1); \
    if ((++_sp & 255u) == 0u) { if (xb_ld(&(bar)[XB_TMO])) break; if (_sp > XB_SPIN_CAP) { atomicAdd(&(bar)[XB_TMO], 1u); break; } } } } while (0)

struct XcdBarrier {
    unsigned* bar; unsigned x;
    volatile LAS unsigned* st;
};

__device__ __forceinline__ XcdBarrier xcd_barrier_post(unsigned* bar, volatile LAS unsigned* st) {
    XcdBarrier b; b.bar = bar; b.x = xb_xcc_id(); b.st = st;
    if (threadIdx.x == 0) (void)xb_add(&bar[XB_XCNT(b.x)], 1u);
    return b;
}
__device__ __forceinline__ void xcd_barrier_complete(unsigned* bar, unsigned x, unsigned& nloc, unsigned& nx) {
    const unsigned G = gridDim.x * gridDim.y * gridDim.z;
    unsigned sum, cnt, mine, sp = 0u;
    for (;;) {
        sum = 0u; cnt = 0u; mine = 0u;
#pragma unroll
        for (unsigned j = 0; j < 16; ++j) { const unsigned c = xb_ld(&bar[XB_XCNT(j)]); sum += c; cnt += (c > 0u) ? 1u : 0u; mine = (j == x) ? c : mine; }
        if (sum == G) break;
        __builtin_amdgcn_s_sleep(1);
        if ((++sp & 255u) == 0u) { if (xb_ld(&bar[XB_TMO])) break; if (sp > XB_SPIN_CAP) { atomicAdd(&bar[XB_TMO], 1u); break; } }
    }
    nloc = mine > 0u ? mine : 1u; nx = cnt > 0u ? cnt : 1u;
}

__device__ __forceinline__ void xcd_barrier(const XcdBarrier& b) {
    asm volatile("s_waitcnt vmcnt(0)" ::: "memory");
    __syncthreads();
    if (threadIdx.x == 0) {
        unsigned* bar = b.bar;
        __builtin_amdgcn_s_waitcnt(0);
        unsigned nloc = b.st[0], nx = b.st[1];
        if (nloc == 0u) { xcd_barrier_complete(bar, b.x, nloc, nx); b.st[0] = nloc; b.st[1] = nx; }
        const unsigned old = xb_add(&bar[XB_XSUB(b.x)], 1u);
        const unsigned gen = old / nloc;
        if (old + 1u == (gen + 1u) * nloc) {
            __builtin_amdgcn_fence(__ATOMIC_RELEASE, "agent");
            asm volatile("s_waitcnt vmcnt(0)" ::: "memory");
            const unsigned og = xb_add(&bar[XB_TOP], 1u);
            const unsigned tg = og / nx;
            if (og + 1u == (tg + 1u) * nx) xb_add(&bar[XB_TOPGEN], 1u);
            else XB_SPIN(xb_ld(&bar[XB_TOPGEN]) == tg, bar);
            __builtin_amdgcn_fence(__ATOMIC_ACQUIRE, "agent");
            xb_add(&bar[XB_XGEN(b.x)], 1u);
            asm volatile("s_waitcnt vmcnt(0)" ::: "memory");
        } else {
            XB_SPIN(xb_ld(&bar[XB_XGEN(b.x)]) == gen, bar);
            __builtin_amdgcn_fence(__ATOMIC_ACQUIRE, "agent");
            asm volatile("s_waitcnt vmcnt(0)" ::: "memory");
        }
    }
    __syncthreads();
}

struct Frame {
    LAS unsigned char* lds;
    volatile LAS unsigned* MISC;
    gu32* ctl;
    int tid, lane, wave;
    int vcu, G;
    unsigned char* ws;
};

__device__ __forceinline__ float wave_sum(float v) {
#pragma unroll
    for (int o = 1; o < 64; o <<= 1) v += __shfl_xor(v, o);
    return v;
}
__device__ __forceinline__ void p0_transpose_item(const float* W, int ldw, int K, int c0, int k0, bf16* WT, int drow, LAS float* scr, int lane) {
#pragma unroll 8
    for (int i = 0; i < 32; ++i) { const int kk = 2 * i + (lane >> 5); scr[kk * 33 + (lane & 31)] = W[(size_t)(k0 + kk) * ldw + c0 + (lane & 31)]; }
    LDS_WAIT(); asm volatile("" ::: "memory");
    const int c = lane & 7;
#pragma unroll
    for (int j = 0; j < 4; ++j) { const int n = (lane >> 3) + 8 * j; const LAS float* s = scr + (8 * c) * 33 + n;
        v4u o; o.x = pk2(s[0 * 33], s[1 * 33]); o.y = pk2(s[2 * 33], s[3 * 33]); o.z = pk2(s[4 * 33], s[5 * 33]); o.w = pk2(s[6 * 33], s[7 * 33]);
        *(GAS v4u*)(WT + (size_t)(drow + n) * K + k0 + 8 * c) = o; }
    LDS_WAIT(); asm volatile("" ::: "memory");
}
#define P0_MATRIX(W, ldw, K, N, WTexpr, DROWexpr) if (!done_) { const int nblk = (N) / 32, nit = ((K) / 64) * nblk; \
    if (r < nit) { const int kb = r / nblk, n0 = (r % nblk) * 32; p0_transpose_item((W), (ldw), (K), n0, kb * 64, (WTexpr), (DROWexpr), scr, F.lane); done_ = true; } else r -= nit; }

struct Args { const float* in[15]; float* out; unsigned char* ws; int ph_lo, ph_hi; };

__device__ __forceinline__ void p0_prologue(Frame& F, const Args& a) {
    LAS float* scr = (LAS float*)(F.lds + RING_OFF + F.wave * 16384);
    const int gw = F.vcu * NWAVES + F.wave, NGW = F.G * NWAVES;
    bf16* W1 = (bf16*)(F.ws + WS_W1); bf16* WV = (bf16*)(F.ws + WS_WV); bf16* WA = (bf16*)(F.ws + WS_WA); bf16* WB = (bf16*)(F.ws + WS_WB);
    bf16* WO = (bf16*)(F.ws + WS_WO); bf16* WGU = (bf16*)(F.ws + WS_WGU); bf16* WD = (bf16*)(F.ws + WS_WD);
    const float *w_in = a.in[1], *w_gate = a.in[3], *w_br_a = a.in[5], *w_br_b = a.in[6], *w_out = a.in[7], *w_ffg = a.in[10], *w_ffu = a.in[11], *w_ffd = a.in[12];
    constexpr int NITEMS = 16 * 120 + 16 * 64 + 16 * 32 + 4 * 32 + 16 * 32 + 16 * 88 * 2 + 44 * 32;
    for (int it = gw; it < NITEMS; it += NGW) {
        int r = it; bool done_ = false;
        P0_MATRIX(w_in, IN_W, 1024, IN_W, ((n0 >= 1280 && n0 < 1536) || n0 >= 3072) ? WV : W1, n0 < 1280 ? n0 : (n0 < 1536 ? n0 - 1280 : (n0 < 3072 ? n0 - 256 : n0 - 3072 + 256)));
        P0_MATRIX(w_gate, 2048, 1024, 2048, W1, 2816 + n0);
        P0_MATRIX(w_br_a, 1024, 1024, 1024, WA, n0);
        P0_MATRIX(w_br_b, 1024, 256, 1024, WB, n0);
        P0_MATRIX(w_out, 1024, 1024, 1024, WO, n0);
        P0_MATRIX(w_ffg, DFF, 1024, DFF, WGU, 256 * (n0 >> 7) + (n0 & 127));
        P0_MATRIX(w_ffu, DFF, 1024, DFF, WGU, 256 * (n0 >> 7) + 128 + (n0 & 127));
        P0_MATRIX(w_ffd, 1024, DFF, 1024, WD, n0);
    }
    const float* x = a.in[0]; bf16* XB = (bf16*)(F.ws + WS_XB);
    for (int m = gw; m < MTOK; m += NGW) {
        const GAS f32x4* xr = (const GAS f32x4*)(x + (size_t)m * DM) + F.lane;
        GAS unsigned long long* o8 = (GAS unsigned long long*)(XB + (size_t)m * DM) + F.lane;
        f32x4 v[4];
#pragma unroll
        for (int j = 0; j < 4; ++j) v[j] = xr[64 * j];
#pragma unroll
        for (int j = 0; j < 4; ++j) o8[64 * j] = (unsigned long long)pk2(v[j].x, v[j].y) | ((unsigned long long)pk2(v[j].z, v[j].w) << 32);
    }
    float* rope = (float*)(F.ws + WS_ROPE);
    for (int e = F.vcu * 512 + F.tid; e < 8192 * 8; e += F.G * 512) {
        const int pos = e >> 3, i = e & 7;
        const float inv = i == 0 ? 1.0f : i == 1 ? 0.1939227432012558f : i == 2 ? 0.03760603070259094f : i == 3 ? 0.007292664609849453f : i == 4 ? 0.0014142135623842478f
                        : i == 5 ? 0.00027424818836152554f : i == 6 ? 5.318296098266728e-05f : 1.0313386155758053e-05f;
        const float ang = (float)pos * inv;
        const double rev = (double)ang * 0.15915494309189535; const float fr = (float)(rev - __builtin_rint(rev));
        rope[pos * 16 + i] = __builtin_amdgcn_cosf(fr); rope[pos * 16 + 8 + i] = __builtin_amdgcn_sinf(fr);
    }
}

__device__ __forceinline__ void ln_rows(Frame& F, const float* in, const float* gam, const float* bet, float* outf, bf16* outb) {
    const int gw = F.vcu * NWAVES + F.wave, NGW = F.G * NWAVES;
    f32x4 gv[4], bv[4];
#pragma unroll
    for (int j = 0; j < 4; ++j) { gv[j] = ((const GAS f32x4*)gam)[F.lane + 64 * j]; bv[j] = ((const GAS f32x4*)bet)[F.lane + 64 * j]; }
    for (int m = gw; m < MTOK; m += NGW) {
        const GAS f32x4* xr = (const GAS f32x4*)(in + (size_t)m * DM) + F.lane;
        f32x4 v[4]; float s = 0.f;
#pragma unroll
        for (int j = 0; j < 4; ++j) { v[j] = xr[64 * j]; s += (v[j].x + v[j].y) + (v[j].z + v[j].w); }
        const float mean = wave_sum(s) * (1.f / DM); float s2 = 0.f;
#pragma unroll
        for (int j = 0; j < 4; ++j) { v[j] = v[j] - mean; s2 += (v[j].x * v[j].x + v[j].y * v[j].y) + (v[j].z * v[j].z + v[j].w * v[j].w); }
        const float rstd = 1.f / sqrtf(wave_sum(s2) * (1.f / DM) + LN_EPS);
        GAS f32x4* of = (GAS f32x4*)(outf + (size_t)m * DM) + F.lane;
#pragma unroll
        for (int j = 0; j < 4; ++j) { v[j] = v[j] * rstd * gv[j] + bv[j]; of[64 * j] = v[j]; }
        if (outb) { GAS unsigned long long* o8 = (GAS unsigned long long*)(outb + (size_t)m * DM) + F.lane;
#pragma unroll
            for (int j = 0; j < 4; ++j) o8[64 * j] = (unsigned long long)pk2(v[j].x, v[j].y) | ((unsigned long long)pk2(v[j].z, v[j].w) << 32); }
    }
}

__global__ void __launch_bounds__(NWAVES * 64, 2) skel_fwd(Args args) {
    extern __shared__ __attribute__((aligned(16))) unsigned char lds[];
    Frame F;
    F.lds = (LAS unsigned char*)lds;
    F.MISC = (volatile LAS unsigned*)(F.lds + MISC_OFF);
    F.tid = threadIdx.x; F.lane = F.tid & 63; F.wave = __builtin_amdgcn_readfirstlane(F.tid >> 6);
    F.G = gridDim.x; { const int bx = blockIdx.x; F.vcu = (F.G % 8 == 0) ? (bx % 8) * (F.G / 8) + bx / 8 : bx; }
    F.ws = args.ws; F.ctl = (gu32*)(args.ws + WS_CTL);
    unsigned char* ws = args.ws;
    for (int u = F.tid; u < (LDS_BYTES - LDSCTL_OFF) / 4; u += NWAVES * 64) ((LAS unsigned*)(F.lds + LDSCTL_OFF))[u] = 0u;
    __syncthreads();
    XcdBarrier bar; bar.bar = (unsigned*)(F.ctl + CW_BAR); bar.x = 0; bar.st = nullptr;
    if (N_LAUNCHES == 1) bar = xcd_barrier_post((unsigned*)(F.ctl + CW_BAR), F.MISC + 8);
#define GRID_BAR() do { if (N_LAUNCHES == 1) xcd_barrier(bar); } while (0)
#define REFRESH() do { int t_ = threadIdx.x; asm volatile("" : "+v"(t_)); F.tid = t_; F.lane = t_ & 63; F.wave = __builtin_amdgcn_readfirstlane(t_ >> 6); } while (0)
    const int lo = args.ph_lo, hi = args.ph_hi;
#define IN(k) (lo <= (k) && (k) < hi)
#define BOTH(k) (IN(k) && IN((k) + 1))
    typedef pg8::bf16_t b16;
    b16* XB = (b16*)(ws + WS_XB); b16* QA = (b16*)(ws + WS_QA); b16* KA = (b16*)(ws + WS_KA); b16* VAT = (b16*)(ws + WS_VAT);
    b16* QB = (b16*)(ws + WS_QB); b16* KB = (b16*)(ws + WS_KB); b16* VBT = (b16*)(ws + WS_VBT); b16* GT = (b16*)(ws + WS_GT);
    b16* OA = XB; b16* OBG = (b16*)(ws + WS_OBG); b16* OB = KA; b16* MX = QA; b16* H1B = XB; b16* TT = (b16*)(ws + WS_T);
    float* ST = (float*)(ws + WS_ST);
    const b16* W1 = (const b16*)(ws + WS_W1); const b16* WV = (const b16*)(ws + WS_WV); const b16* WA = (const b16*)(ws + WS_WA); const b16* WB = (const b16*)(ws + WS_WB);
    const b16* WO = (const b16*)(ws + WS_WO); const b16* WGU = (const b16*)(ws + WS_WGU); const b16* WD = (const b16*)(ws + WS_WD);
    const int G = F.G, bx = (int)blockIdx.x;

    if (IN(0)) { REFRESH(); p0_prologue(F, args); if (BOTH(0)) GRID_BAR(); }

    if (IN(1)) { REFRESH();
        { pg8::Gemm g{XB, W1, MTOK, 4864, 1024, 1}; pg8::StaticOrder S; S.init(MTOK, 4864, G, bx);
          pg8::EpiProj E{QA, KA, QB, KB, GT, (const float*)(ws + WS_ROPE), args.in[4]};
          pg8::gemm_phase<pg8::EpiProj, pg8::StaticOrder, true, true>(F.lds + RING_OFF, g, S, E); }
        { pg8::Gemm g{WV, XB, 512, MTOK, 1024, 1}; pg8::StaticOrder S; S.init(512, MTOK, G, bx);
          pg8::EpiVT E{{VAT, VBT}, {4, 12}, {0, 0}};
          pg8::gemm_phase<pg8::EpiVT, pg8::StaticOrder, true, true>(F.lds + RING_OFF, g, S, E); }
        { pg8::Gemm g{WV + (size_t)512 * 1024, XB, 256, MTOK, 1024, 4}; pg8::StaticOrder S; S.init(256, MTOK, G, bx);
          pg8::EpiVT E{{VBT, VBT}, {12, 12}, {4, 4}};
          pg8::gemm_phase<pg8::EpiVT, pg8::StaticOrder, true, true>(F.lds + RING_OFF, g, S, E); }
        { pg8::Gemm g{WV + (size_t)768 * 1024, XB, 256, MTOK, 1024, 16}; pg8::StaticOrder S; S.init(256, MTOK, G, bx);
          pg8::EpiVT E{{VBT, VBT}, {12, 12}, {8, 8}};
          pg8::gemm_phase<pg8::EpiVT, pg8::StaticOrder, true, true>(F.lds + RING_OFF, g, S, E); }
        if (BOTH(1)) GRID_BAR();
    }

    if (IN(2)) { REFRESH();
        const int lane = F.lane, w = F.wave, r32 = lane & 31, hi = lane >> 5;
        const float* sink = args.in[2];
        for (int k = 0; k < 16; ++k) {
            const int U = F.vcu * 16 + k, strip = U >> 7, blk = U & 127, b = strip >> 2, kvh = strip & 3;
            const int h = kvh * 4 + (w >> 1), q0 = blk * 64 + 32 * (w & 1);
            att::f32x16 o[2]; float m, l;
            att::wave_attn<128>(QA + (size_t)(b * 8192 + q0) * 1024 + h * 64, 1024, (const char*)(KA + (size_t)strip * 128 * 4096), (const char*)(VAT + (size_t)strip * 128 * 4096),
                                128, q0, sink[h] * LOG2E, 1.0f, o, m, l, lane);
            att::store_o(OA + (size_t)(b * 8192 + q0 + r32) * 1024 + h * 64, o, 1.0f / l, hi);
        }
        for (int k = 0; k < 12; ++k) {
            const int U = F.vcu * 12 + k, blk = U & 31, hs = (U >> 5) & 3, bg = U >> 7, g = bg % 3, b = bg / 3;
            const int p0 = blk * 256 + 32 * w;
            const int L = g == 0 ? 8192 : (g == 1 ? 2048 : 512), seq = p0 / L, q0 = p0 % L;
            const size_t tile0 = (size_t)(((b * 3 + g) * 4 + hs) * 128 + seq * (L >> 6));
            att::f32x16 o[2]; float m, l;
            att::wave_attn<64>(QB + (size_t)(b * 8192 + p0) * 768 + g * 256 + hs * 64, 768, (const char*)(KB + tile0 * 4096), (const char*)(VBT + tile0 * 4096),
                               L >> 6, q0, -1e30f, 0.0f, o, m, l, lane);
            const int pq = q0 + r32, t = g == 0 ? pq : (g == 1 ? pq * 4 + seq : pq * 16 + seq);
            const size_t tok = (size_t)b * 8192 + t;
            att::store_o(OBG + ((size_t)g * MTOK + tok) * 256 + hs * 64, o, 1.0f / l, hi);
            if (hi == 0) { float* sp = ST + (((size_t)g * MTOK + tok) * 4 + hs) * 2; sp[0] = m; sp[1] = l; }
        }
        if (BOTH(2)) GRID_BAR();
    }

    if (IN(3)) { REFRESH();
        for (size_t it = (size_t)F.vcu * 512 + F.tid; it < (size_t)MTOK * 32; it += (size_t)G * 512) {
            const size_t tok = it >> 5; const int hs = (int)(it >> 3) & 3, dc = (int)it & 7;
            float mg[3], lg[3];
#pragma unroll
            for (int g = 0; g < 3; ++g) { const float* sp = ST + (((size_t)g * MTOK + tok) * 4 + hs) * 2; mg[g] = sp[0]; lg[g] = sp[1]; }
            const float M = fmaxf(mg[0], fmaxf(mg[1], mg[2]));
            float wg[3], ws_ = 0.f;
#pragma unroll
            for (int g = 0; g < 3; ++g) { wg[g] = lg[g] * __builtin_amdgcn_exp2f(mg[g] - M); ws_ += wg[g]; }
            const float inv = 1.0f / ws_;
            float acc[8] = {0.f, 0.f, 0.f, 0.f, 0.f, 0.f, 0.f, 0.f};
#pragma unroll
            for (int g = 0; g < 3; ++g) { const v4u v = *(const v4u*)(OBG + ((size_t)g * MTOK + tok) * 256 + hs * 64 + dc * 8); const float wq = wg[g] * inv;
                acc[0] += wq * pg8::bf_lo(v.x); acc[1] += wq * pg8::bf_hi(v.x); acc[2] += wq * pg8::bf_lo(v.y); acc[3] += wq * pg8::bf_hi(v.y);
                acc[4] += wq * pg8::bf_lo(v.z); acc[5] += wq * pg8::bf_hi(v.z); acc[6] += wq * pg8::bf_lo(v.w); acc[7] += wq * pg8::bf_hi(v.w); }
            v4u o; o.x = pk2(acc[0], acc[1]); o.y = pk2(acc[2], acc[3]); o.z = pk2(acc[4], acc[5]); o.w = pk2(acc[6], acc[7]);
            *(v4u*)(OB + tok * 256 + hs * 64 + dc * 8) = o;
        }
        if (BOTH(3)) GRID_BAR();
    }

    if (IN(4)) { REFRESH();
        { pg8::Gemm g{OB, WB, MTOK, 1024, 256, 1}; pg8::StaticOrder S; S.init(MTOK, 1024, G, bx);
          pg8::EpiGate<true> E{MX, GT, 1024};
          pg8::gemm_phase<pg8::EpiGate<true>, pg8::StaticOrder, true, true>(F.lds + RING_OFF, g, S, E); }
        { pg8::Gemm g{OA, WA, MTOK, 1024, 1024, 1}; pg8::StaticOrder S; S.init(MTOK, 1024, G, bx);
          pg8::EpiGate<false> E{MX, GT, 0};
          pg8::gemm_phase<pg8::EpiGate<false>, pg8::StaticOrder, true, true>(F.lds + RING_OFF, g, S, E); }
        if (BOTH(4)) GRID_BAR();
    }

    if (IN(5)) { REFRESH();
        pg8::Gemm g{MX, WO, MTOK, 1024, 1024, 1}; pg8::StaticOrder S; S.init(MTOK, 1024, G, bx);
        pg8::EpiRes E{args.in[0], args.out, 1};
        pg8::gemm_phase<pg8::EpiRes, pg8::StaticOrder, true, true>(F.lds + RING_OFF, g, S, E);
        if (BOTH(5)) GRID_BAR();
    }
    if (IN(6)) { REFRESH(); ln_rows(F, args.out, args.in[8], args.in[9], args.out, (bf16*)H1B); if (BOTH(6)) GRID_BAR(); }

    if (IN(7)) { REFRESH();
        pg8::Gemm g{H1B, WGU, MTOK, 5632, 1024, 1}; pg8::StaticOrder S; S.init(MTOK, 5632, G, bx);
        pg8::EpiSwiGLU E{TT};
        pg8::gemm_phase<pg8::EpiSwiGLU, pg8::StaticOrder, true, true>(F.lds + RING_OFF, g, S, E);
        if (BOTH(7)) GRID_BAR();
    }
    if (IN(8)) { REFRESH();
        pg8::Gemm g{TT, WD, MTOK, 1024, DFF, 1}; pg8::StaticOrder S; S.init(MTOK, 1024, G, bx);
        pg8::EpiRes E{args.out, args.out, 0};
        pg8::gemm_phase<pg8::EpiRes, pg8::StaticOrder, true, true>(F.lds + RING_OFF, g, S, E);
        if (BOTH(8)) GRID_BAR();
    }
    if (IN(9)) { REFRESH(); ln_rows(F, args.out, args.in[13], args.in[14], args.out, nullptr); }
#undef IN
#undef BOTH
}

extern "C" void kernel_launch(void* const* d_in, const int* in_sizes, int n_in, void* d_out, int out_size, void* d_ws, size_t ws_size, hipStream_t stream) {
    static int grid = 0;
    if (grid == 0) {
        if (n_in != 15 || in_sizes[0] != MTOK * DM || out_size != MTOK * DM || ws_size < WS_END) {
            fprintf(stderr, "kernel_launch: unexpected problem: n_in %d in0 %d out %d ws %zu (need %zu); nothing launched\n", n_in, n_in > 0 ? in_sizes[0] : -1, out_size, ws_size, (size_t)WS_END); grid = -1; return; }
        int dev = 0, cus = 0, per_cu = 0;
        if (hipGetDevice(&dev) != hipSuccess || hipDeviceGetAttribute(&cus, hipDeviceAttributeMultiprocessorCount, dev) != hipSuccess) { fprintf(stderr, "kernel_launch: device query failed\n"); grid = -1; return; }
        if (hipFuncSetAttribute((const void*)skel_fwd, hipFuncAttributeMaxDynamicSharedMemorySize, LDS_BYTES) != hipSuccess) { fprintf(stderr, "kernel_launch: hipFuncSetAttribute failed\n"); grid = -1; return; }
        if (hipOccupancyMaxActiveBlocksPerMultiprocessor(&per_cu, (const void*)skel_fwd, NWAVES * 64, LDS_BYTES) != hipSuccess || per_cu < 1)
            fprintf(stderr, "kernel_launch: note: occupancy query reports %d workgroups per CU\n", per_cu);
        (void)hipGetLastError();
        grid = cus;
        if (grid != 256) fprintf(stderr, "kernel_launch: note: %d CUs (built for 256)\n", grid);
    }
    if (grid < 0) return;
    if (hipMemsetAsync((char*)d_ws + WS_CTL, 0, CTL_ZERO_BYTES, stream) != hipSuccess) { fprintf(stderr, "kernel_launch: memset failed\n"); return; }
    Args a{};
    for (int i = 0; i < 15; ++i) a.in[i] = (const float*)d_in[i];
    a.out = (float*)d_out; a.ws = (unsigned char*)d_ws;
    for (int li = 0; li < N_LAUNCHES; ++li) {
        a.ph_lo = (N_LAUNCHES == PER_PHASE) ? li : 0; a.ph_hi = (N_LAUNCHES == PER_PHASE) ? li + 1 : PER_PHASE;
        hipLaunchKernelGGL(skel_fwd, dim3(grid), dim3(NWAVES * 64), LDS_BYTES, stream, a);
        const hipError_t le = hipPeekAtLastError();
        if (le != hipSuccess) { fprintf(stderr, "kernel_launch: launch %d failed: %s\n", li, hipGetErrorName(le)); break; }
    }
}
```

```cpp
#include <hip/hip_runtime.h>
#include <cstdio>
#include <cstdint>

#ifndef MK_N_LAUNCHES
#define MK_N_LAUNCHES 1
#endif

constexpr int BATCH = 8, SEQ = 8192, DM = 1024, MTOK = BATCH * SEQ;
constexpr int IN_W = 3840, DFF = 2816;
constexpr float LN_EPS = 1e-5f, DN_ALPHA = 1.189207115002721f;
constexpr float QSCALE = 0.18033688011112042f;
constexpr float LOG2E = 1.4426950408889634f;

__host__ __device__ __forceinline__ int img_off(int rho, int c) { return (rho >> 1) * 256 + (((((rho & 1) << 3) | c) ^ ((rho >> 1) & 7)) << 4); }

namespace pg8 {
#define PG8_LAS __attribute__((address_space(3)))
typedef unsigned short bf16_t;
typedef short bf16x8 __attribute__((ext_vector_type(8)));
typedef float f32x4 __attribute__((ext_vector_type(4)));
typedef unsigned u32x4 __attribute__((ext_vector_type(4)));
typedef unsigned u32x2 __attribute__((ext_vector_type(2)));
constexpr int BM = 256, BK = 64, HALF = 128, HTB = HALF * BK * 2  , STAGE_BYTES = 8 * HTB, NXCD = 8, WGM = 8;

__host__ __device__ __forceinline__ int lds_byte(int r, int c) { const int st = (r >> 4) * 2 + (c >> 5), rr = r & 15, cc = c & 31, ob = rr * 64 + cc * 2; return st * 1024 + (ob ^ (((ob >> 9) & 1) << 5)); }
__host__ __device__ __forceinline__ void stage_rc(int b, int& R, int& C) { const int st = b / 1024, sb = b % 1024, swz = sb ^ (((sb >> 9) & 1) << 5); R = (st >> 1) * 16 + swz / 64; C = (st & 1) * 32 + (swz % 64) / 2; }
__host__ __device__ __forceinline__ int perm32(int rho) { const int n = rho >> 4, i = rho & 15; return 8 * (i >> 2) + 4 * n + (i & 3); }

struct Unit { int pm, pn; };
struct Gemm { const bf16_t* A; const bf16_t* Bt; int M, N, K; int bmul; };

__device__ __forceinline__ size_t b_unit_off(const Gemm& g, int pn) {
    if (g.bmul == 1) return (size_t)pn * 256 * (size_t)g.K * 2;
    const int P0 = pn * 256, b = P0 >> 13, p = P0 & 8191, L = 8192 / g.bmul, seq = p / L, pos = p % L;
    return (size_t)(b * 8192 + pos * g.bmul + seq) * (size_t)g.K * 2;
}

struct StaticOrder {
    int nM, nN, nwg, G, c;
    __host__ __device__ void init(int M, int N, int G_, int c_) { nM = M / BM; nN = N / BM; nwg = nM * nN; G = G_; c = c_; }
    __host__ __device__ bool next(int i, Unit& u) const {
        const long L = (long)i * G + c; if (L >= nwg) return false;
        int wgid = (int)L; { const int q = nwg / NXCD, r = nwg % NXCD, xcd = wgid % NXCD, off = wgid / NXCD; wgid = (xcd < r ? xcd * (q + 1) : r * (q + 1) + (xcd - r) * q) + off; }
        const int nig = WGM * nN, gid = wgid / nig, fm = gid * WGM, gsz = (nM - fm) < WGM ? (nM - fm) : WGM;
        u.pm = fm + ((wgid % nig) % gsz); u.pn = (wgid % nig) / gsz; return true;
    }
    __device__ __forceinline__ void a_ready(const Unit&) const {}
    __device__ __forceinline__ void done(const Unit&) const {}
};

typedef float f32x2_t __attribute__((ext_vector_type(2))); typedef __bf16 bf16x2_t __attribute__((ext_vector_type(2)));
__device__ __forceinline__ unsigned cvt_pk_bf16(float lo, float hi) { f32x2_t v = {lo, hi}; bf16x2_t b = __builtin_convertvector(v, bf16x2_t); return __builtin_bit_cast(unsigned, b); }
__device__ __forceinline__ float bf_lo(unsigned w) { return __uint_as_float(w << 16); }
__device__ __forceinline__ float bf_hi(unsigned w) { return __uint_as_float(w & 0xffff0000u); }
__device__ __forceinline__ float sigmoidf_(float z) { return __builtin_amdgcn_rcpf(1.0f + __builtin_amdgcn_exp2f(-z * LOG2E)); }
__device__ __forceinline__ u32x4 pack8(const f32x4 a, const f32x4 b) { u32x4 w; w.x = cvt_pk_bf16(a[0], a[1]); w.y = cvt_pk_bf16(a[2], a[3]); w.z = cvt_pk_bf16(b[0], b[1]); w.w = cvt_pk_bf16(b[2], b[3]); return w; }


struct EpiProj {
    static constexpr bool PERM = true, AFTER_DRAIN = false;
    bf16_t *QA, *KA, *QB, *KB, *GT; const float* rope; const float* bgate;
    __device__ __forceinline__ void operator()(const f32x4 (&acc)[2][2][4][2], const Unit& u, int wr, int wc, int fr, int fq) const {
        const int pn = u.pn, row0 = u.pm * BM + wr * 64 + fr;
        if (pn >= 11) {
            const int col0 = (pn - 11) * 256 + wc * 32 + 8 * fq;
            f32x4 bv[2][2];
#pragma unroll
            for (int bj = 0; bj < 2; ++bj)
#pragma unroll
                for (int n = 0; n < 2; ++n) bv[bj][n] = *(const f32x4*)(bgate + col0 + bj * HALF + 4 * n);
#pragma unroll
            for (int ai = 0; ai < 2; ++ai)
#pragma unroll
                for (int m = 0; m < 4; ++m) { bf16_t* rowp = GT + (size_t)(row0 + ai * HALF + m * 16) * 2048 + col0;
#pragma unroll
                    for (int bj = 0; bj < 2; ++bj) { f32x4 v0 = acc[ai][bj][m][0] + bv[bj][0], v1 = acc[ai][bj][m][1] + bv[bj][1];
#pragma unroll
                        for (int e = 0; e < 4; ++e) { v0[e] = sigmoidf_(v0[e]); v1[e] = sigmoidf_(v1[e]); }
                        *(u32x4*)(rowp + bj * HALF) = pack8(v0, v1); } }
            return;
        }
        const int typ = pn < 4 ? 0 : (pn == 4 ? 1 : (pn < 8 ? 2 : 3));
        const int grp = typ == 2 ? pn - 5 : (typ == 3 ? pn - 8 : 0);
        const float sc = (typ == 0 || typ == 2) ? QSCALE : 1.0f;
        const bool rot_wave = (wc & 1) == 0, rot_lane = fq < 2;
        const float sgn = fq == 0 ? -1.0f : 1.0f;
        const int chunk = 4 * (wc & 1) + fq;
#pragma unroll
        for (int ai = 0; ai < 2; ++ai)
#pragma unroll
            for (int m = 0; m < 4; ++m) {
                const int tg = row0 + ai * HALF + m * 16, b = tg >> 13, t = tg & 8191;
                f32x4 c0 = {1.f, 1.f, 1.f, 1.f}, c1 = c0, s0 = {0.f, 0.f, 0.f, 0.f}, s1 = s0;
                if (rot_wave && rot_lane) { const f32x4* rp = (const f32x4*)(rope + (size_t)t * 16); c0 = rp[0]; c1 = rp[1]; s0 = rp[2] * sgn; s1 = rp[3] * sgn; }
                const int p = grp == 0 ? t : (grp == 1 ? ((t & 3) * 2048 + (t >> 2)) : ((t & 15) * 512 + (t >> 4)));
#pragma unroll
                for (int bj = 0; bj < 2; ++bj) {
                    f32x4 v0 = acc[ai][bj][m][0], v1 = acc[ai][bj][m][1];
                    if (rot_wave) {
                        f32x4 q0, q1;
#pragma unroll
                        for (int e = 0; e < 4; ++e) { q0[e] = __shfl_xor(v0[e], 16); q1[e] = __shfl_xor(v1[e], 16); }
                        v0 = v0 * c0 + q0 * s0; v1 = v1 * c1 + q1 * s1;
                    }
                    v0 = v0 * sc; v1 = v1 * sc;
                    const int cl = bj * HALF + wc * 32 + 8 * fq, hh = 2 * bj + (wc >> 1);
                    bf16_t* dst;
                    if (typ == 0)      dst = QA + (size_t)tg * 1024 + pn * 256 + cl;
                    else if (typ == 1) dst = KA + ((size_t)((b * 4 + hh) * 128 + (t >> 6))) * 4096 + (img_off(t & 63, chunk) >> 1);
                    else if (typ == 2) dst = QB + (size_t)(b * 8192 + p) * 768 + grp * 256 + cl;
                    else               dst = KB + ((size_t)(((b * 3 + grp) * 4 + hh) * 128 + (p >> 6))) * 4096 + (img_off(p & 63, chunk) >> 1);
                    *(u32x4*)dst = pack8(v0, v1);
                }
            }
    }
};
struct EpiVT {
    static constexpr bool PERM = true, AFTER_DRAIN = false;
    bf16_t* dst[2]; int nhb[2], hoff[2];
    __device__ __forceinline__ void operator()(const f32x4 (&acc)[2][2][4][2], const Unit& u, int wr, int wc, int fr, int fq) const {
        bf16_t* base = u.pm == 0 ? dst[0] : dst[1]; const int nh = u.pm == 0 ? nhb[0] : nhb[1], ho = u.pm == 0 ? hoff[0] : hoff[1];
        const int P0 = u.pn * BM, b = P0 >> 13, j0 = (P0 & 8191) >> 6, chunk = 4 * (wc & 1) + fq;
#pragma unroll
        for (int ai = 0; ai < 2; ++ai)
#pragma unroll
            for (int m = 0; m < 4; ++m) { const int hh = 2 * ai + wr, d = m * 16 + fr;
#pragma unroll
                for (int bj = 0; bj < 2; ++bj) { const int j = j0 + 2 * bj + (wc >> 1);
                    bf16_t* p = base + ((size_t)((b * nh + ho + hh) * 128 + j)) * 4096 + (img_off(d, chunk) >> 1);
                    *(u32x4*)p = pack8(acc[ai][bj][m][0], acc[ai][bj][m][1]); } }
    }
};
template <bool FIRST> struct EpiGate {
    static constexpr bool PERM = true, AFTER_DRAIN = false;
    bf16_t* MX; const bf16_t* GT; int goff;
    __device__ __forceinline__ void operator()(const f32x4 (&acc)[2][2][4][2], const Unit& u, int wr, int wc, int fr, int fq) const {
        const int row0 = u.pm * BM + wr * 64 + fr, col0 = u.pn * BM + wc * 32 + 8 * fq;
#pragma unroll
        for (int ai = 0; ai < 2; ++ai)
#pragma unroll
            for (int m = 0; m < 4; ++m) { const size_t r = (size_t)(row0 + ai * HALF + m * 16);
#pragma unroll
                for (int bj = 0; bj < 2; ++bj) {
                    const u32x4 gw = *(const u32x4*)(GT + r * 2048 + goff + col0 + bj * HALF);
                    f32x4 v0 = acc[ai][bj][m][0], v1 = acc[ai][bj][m][1];
                    v0[0] *= bf_lo(gw.x); v0[1] *= bf_hi(gw.x); v0[2] *= bf_lo(gw.y); v0[3] *= bf_hi(gw.y);
                    v1[0] *= bf_lo(gw.z); v1[1] *= bf_hi(gw.z); v1[2] *= bf_lo(gw.w); v1[3] *= bf_hi(gw.w);
                    bf16_t* dp = MX + r * 1024 + col0 + bj * HALF;
                    if (!FIRST) { const u32x4 ow = *(const u32x4*)dp;
                        v0[0] += bf_lo(ow.x); v0[1] += bf_hi(ow.x); v0[2] += bf_lo(ow.y); v0[3] += bf_hi(ow.y);
                        v1[0] += bf_lo(ow.z); v1[1] += bf_hi(ow.z); v1[2] += bf_lo(ow.w); v1[3] += bf_hi(ow.w); }
                    *(u32x4*)dp = pack8(v0, v1); } }
    }
};
struct EpiRes {
    static constexpr bool PERM = false, AFTER_DRAIN = false;
    const float* base; float* out; int noy;
    __device__ __forceinline__ void operator()(const f32x4 (&acc)[2][2][4][2], const Unit& u, int wr, int wc, int fr, int fq) const {
        const int row0 = u.pm * BM + wr * 64 + fr, col0 = u.pn * BM + wc * 32 + 4 * fq;
#pragma unroll
        for (int ai = 0; ai < 2; ++ai)
#pragma unroll
            for (int m = 0; m < 4; ++m) { const size_t off = (size_t)(row0 + ai * HALF + m * 16) * 1024 + col0;
#pragma unroll
                for (int bj = 0; bj < 2; ++bj)
#pragma unroll
                    for (int n = 0; n < 2; ++n) { const f32x4 bs = *(const f32x4*)(base + off + bj * HALF + n * 16);
#ifdef DBG_NOY
                        *(f32x4*)(out + off + bj * HALF + n * 16) = bs * DN_ALPHA + (noy ? acc[ai][bj][m][n] * 0.0f : acc[ai][bj][m][n]); } }
#else
                        *(f32x4*)(out + off + bj * HALF + n * 16) = bs * DN_ALPHA + acc[ai][bj][m][n]; } }
#endif
    }
};
struct EpiSwiGLU {
    static constexpr bool PERM = true, AFTER_DRAIN = false;
    bf16_t* T;
    __device__ __forceinline__ void operator()(const f32x4 (&acc)[2][2][4][2], const Unit& u, int wr, int wc, int fr, int fq) const {
        const int row0 = u.pm * BM + wr * 64 + fr, col0 = u.pn * HALF + wc * 32 + 8 * fq;
#pragma unroll
        for (int ai = 0; ai < 2; ++ai)
#pragma unroll
            for (int m = 0; m < 4; ++m) { f32x4 v0, v1;
#pragma unroll
                for (int e = 0; e < 4; ++e) { const float g0 = acc[ai][0][m][0][e], g1 = acc[ai][0][m][1][e];
                    v0[e] = g0 * sigmoidf_(g0) * acc[ai][1][m][0][e]; v1[e] = g1 * sigmoidf_(g1) * acc[ai][1][m][1][e]; }
                *(u32x4*)(T + (size_t)(row0 + ai * HALF + m * 16) * DFF + col0) = pack8(v0, v1); }
    }
};

template <class Epi, class Sched, bool ALIGN_EPI = false, bool SP2 = false>
__device__ __forceinline__ void gemm_phase(PG8_LAS unsigned char* lds, const Gemm g, const Sched& S, const Epi& E) {
    int tid_ = threadIdx.x; asm volatile("" : "+v"(tid_));
    const int tid = tid_, wid = __builtin_amdgcn_readfirstlane(tid >> 6), lane = tid & 63, wr = wid >> 2, wc = wid & 3, fr = lane & 15, fq = lane >> 4;
    const int K = g.K, nt = K / BK;
    unsigned voffA[2], voffB[2];
#pragma unroll
    for (int i = 0; i < 2; ++i) { int R, C; stage_rc(tid * 16 + i * 8192, R, C); const int Rb = Epi::PERM ? ((R & ~31) + perm32(R & 31)) : R;
        voffA[i] = (unsigned)(R * K + C) * 2u; voffB[i] = (unsigned)(Rb * K * g.bmul + C) * 2u; }
    const size_t kstep = (size_t)(BK * 2);
    const size_t hstep = (size_t)HALF * K * 2;
    const size_t tstep = 2 * hstep;   const size_t hstepB = hstep * (size_t)g.bmul;
    const unsigned ldsw = (unsigned)wid * 1024u;
    const int aoff = lds_byte(wr * 64 + fr, fq * 8), boff = lds_byte(wc * 32 + fr, fq * 8);
#define PG8_SA(b, h) (((b) * 2 + (h)) * HTB)
#define PG8_SB(b, h) ((4 + (b) * 2 + (h)) * HTB)
#define PG8_STAGE(bufoff, gbase, voff) do { _Pragma("unroll") for (int _i = 0; _i < 2; ++_i) \
        __builtin_amdgcn_global_load_lds((const unsigned*)((const char*)(gbase) + (voff)[_i]), (PG8_LAS unsigned*)(lds + (bufoff) + ldsw + _i * 8192), 16, 0, 0); } while (0)
#define PG8_LDA(dst, b, h) do { _Pragma("unroll") for (int m = 0; m < 4; ++m) _Pragma("unroll") for (int k = 0; k < 2; ++k) dst[m][k] = *(const PG8_LAS bf16x8*)(lds + PG8_SA(b, h) + aoff + m * 2048 + k * 1024); } while (0)
#define PG8_LDB(dst, b, h) do { _Pragma("unroll") for (int n = 0; n < 2; ++n) _Pragma("unroll") for (int k = 0; k < 2; ++k) dst[n][k] = *(const PG8_LAS bf16x8*)(lds + PG8_SB(b, h) + boff + n * 2048 + k * 1024); } while (0)
#define PG8_MMA(ai, bj, At, Bt) do { __builtin_amdgcn_s_setprio(1); _Pragma("unroll") for (int m = 0; m < 4; ++m) _Pragma("unroll") for (int n = 0; n < 2; ++n) _Pragma("unroll") for (int k = 0; k < 2; ++k) \
        acc[ai][bj][m][n] = __builtin_amdgcn_mfma_f32_16x16x32_bf16(Bt[n][k], At[m][k], acc[ai][bj][m][n], 0, 0, 0); __builtin_amdgcn_s_setprio(0); } while (0)
#define PG8_WAIT_V(n) asm volatile("s_waitcnt vmcnt(" #n ")" ::: "memory")
#define PG8_WAIT_L(n) asm volatile("s_waitcnt lgkmcnt(" #n ")" ::: "memory")
#define PG8_BAR __builtin_amdgcn_s_barrier()
#define PG8_SCHED __builtin_amdgcn_sched_barrier(0)
    Unit cur, nxt; int ui = 0;
    if (!S.next(0, cur)) return;
    f32x4 acc[2][2][4][2];
#pragma unroll
    for (int a = 0; a < 2; ++a)
#pragma unroll
        for (int b = 0; b < 2; ++b)
#pragma unroll
            for (int m = 0; m < 4; ++m)
#pragma unroll
                for (int n = 0; n < 2; ++n) acc[a][b][m][n] = (f32x4){0.f, 0.f, 0.f, 0.f};
    bf16x8 At[4][2], B0[2][2], B1[2][2];
    const char* cA = (const char*)g.A + (size_t)cur.pm * tstep; const char* cB = (const char*)g.Bt + b_unit_off(g, cur.pn);
    S.a_ready(cur);
    if constexpr (SP2) {
        PG8_STAGE(PG8_SB(0, 0), cB, voffB); PG8_STAGE(PG8_SB(0, 1), cB + hstepB, voffB); PG8_STAGE(PG8_SA(0, 0), cA, voffA); PG8_STAGE(PG8_SA(0, 1), cA + hstep, voffA);
        if (wr == 1) PG8_BAR;
        PG8_WAIT_V(2); PG8_BAR;
        PG8_STAGE(PG8_SB(1, 0), cB + kstep, voffB); PG8_STAGE(PG8_SA(1, 0), cA + kstep, voffA); PG8_STAGE(PG8_SB(1, 1), cB + hstepB + kstep, voffB);
        PG8_WAIT_V(6); PG8_BAR;
    } else {
        PG8_STAGE(PG8_SB(0, 0), cB, voffB); PG8_STAGE(PG8_SA(0, 0), cA, voffA); PG8_STAGE(PG8_SB(0, 1), cB + hstepB, voffB); PG8_STAGE(PG8_SA(0, 1), cA + hstep, voffA);
        if (wr == 1) PG8_BAR;
        PG8_WAIT_V(4); PG8_BAR;
        PG8_STAGE(PG8_SB(1, 0), cB + kstep, voffB); PG8_STAGE(PG8_SA(1, 0), cA + kstep, voffA); PG8_STAGE(PG8_SB(1, 1), cB + hstepB + kstep, voffB);
        PG8_WAIT_V(6); PG8_BAR;
    }
    for (;;) {
        const bool has_next = S.next(ui + 1, nxt);
        const char* nA = has_next ? (const char*)g.A + (size_t)nxt.pm * tstep : cA; const char* nB = has_next ? (const char*)g.Bt + b_unit_off(g, nxt.pn) : cB;
        for (int t = 0; t < nt; t += 2) {
            const bool last = (t == nt - 2);
            const char* a1 = cA + (size_t)(t + 1) * kstep;
            const char* a2 = last ? nA : cA + (size_t)(t + 2) * kstep; const char* b2 = last ? nB : cB + (size_t)(t + 2) * kstep;
            const char* a3 = a2 + kstep; const char* b3 = b2 + kstep;
            if (last && has_next) S.a_ready(nxt);
            if constexpr (SP2) {
            PG8_LDB(B0, 0, 0); PG8_LDB(B1, 0, 1); PG8_SCHED; PG8_LDA(At, 0, 0); PG8_STAGE(PG8_SA(1, 1), a1 + hstep, voffA);
            PG8_WAIT_V(8); PG8_WAIT_L(0); PG8_BAR; PG8_MMA(0, 0, At, B0); PG8_MMA(0, 1, At, B1); PG8_BAR; PG8_SCHED;
            PG8_LDA(At, 0, 1); PG8_STAGE(PG8_SB(0, 0), b2, voffB); PG8_STAGE(PG8_SB(0, 1), b2 + hstepB, voffB); PG8_STAGE(PG8_SA(0, 0), a2, voffA);
            PG8_WAIT_V(8); PG8_WAIT_L(0); PG8_BAR; PG8_MMA(1, 0, At, B0); PG8_MMA(1, 1, At, B1); PG8_BAR; PG8_SCHED;
            PG8_LDB(B0, 1, 0); PG8_LDB(B1, 1, 1); PG8_SCHED; PG8_LDA(At, 1, 0); PG8_STAGE(PG8_SA(0, 1), a2 + hstep, voffA);
            PG8_WAIT_V(8); PG8_WAIT_L(0); PG8_BAR; PG8_MMA(0, 0, At, B0); PG8_MMA(0, 1, At, B1); PG8_BAR; PG8_SCHED;
            PG8_LDA(At, 1, 1); PG8_STAGE(PG8_SB(1, 0), b3, voffB); PG8_STAGE(PG8_SB(1, 1), b3 + hstepB, voffB); PG8_STAGE(PG8_SA(1, 0), a3, voffA);
            PG8_WAIT_V(8); PG8_WAIT_L(0); PG8_BAR; PG8_MMA(1, 0, At, B0); PG8_MMA(1, 1, At, B1); PG8_BAR; PG8_SCHED;
            } else {
            PG8_LDB(B0, 0, 0); PG8_SCHED; PG8_LDA(At, 0, 0); PG8_STAGE(PG8_SA(1, 1), a1 + hstep, voffA);
            PG8_WAIT_L(8); PG8_BAR; PG8_WAIT_L(0); PG8_MMA(0, 0, At, B0); PG8_BAR; PG8_SCHED;
            PG8_LDB(B1, 0, 1); PG8_STAGE(PG8_SB(0, 0), b2, voffB);
            PG8_BAR; PG8_WAIT_L(0); PG8_MMA(0, 1, At, B1); PG8_BAR;
            PG8_LDA(At, 0, 1); PG8_STAGE(PG8_SA(0, 0), a2, voffA);
            PG8_BAR; PG8_WAIT_L(0); PG8_MMA(1, 0, At, B0); PG8_BAR; PG8_SCHED;
            PG8_STAGE(PG8_SB(0, 1), b2 + hstepB, voffB);
            PG8_WAIT_V(6); PG8_BAR; PG8_MMA(1, 1, At, B1); PG8_BAR;
            PG8_LDB(B0, 1, 0); PG8_SCHED; PG8_LDA(At, 1, 0); PG8_STAGE(PG8_SA(0, 1), a2 + hstep, voffA);
            PG8_WAIT_L(8); PG8_BAR; PG8_WAIT_L(0); PG8_MMA(0, 0, At, B0); PG8_BAR; PG8_SCHED;
            PG8_LDB(B1, 1, 1); PG8_STAGE(PG8_SB(1, 0), b3, voffB);
            PG8_BAR; PG8_WAIT_L(0); PG8_MMA(0, 1, At, B1); PG8_BAR;
            PG8_LDA(At, 1, 1); PG8_STAGE(PG8_SA(1, 0), a3, voffA);
            PG8_BAR; PG8_WAIT_L(0); PG8_MMA(1, 0, At, B0); PG8_BAR; PG8_SCHED;
            PG8_STAGE(PG8_SB(1, 1), b3 + hstepB, voffB);
            PG8_WAIT_V(6); PG8_BAR; PG8_MMA(1, 1, At, B1); PG8_BAR;
            }
        }
        if constexpr (ALIGN_EPI) { if (wr == 0) PG8_BAR; }
        if constexpr (!Epi::AFTER_DRAIN) { E(acc, cur, wr, wc, fr, fq); S.done(cur); }
        if (!has_next) break;
#pragma unroll
        for (int a = 0; a < 2; ++a)
#pragma unroll
            for (int b = 0; b < 2; ++b)
#pragma unroll
                for (int m = 0; m < 4; ++m)
#pragma unroll
                    for (int n = 0; n < 2; ++n) acc[a][b][m][n] = (f32x4){0.f, 0.f, 0.f, 0.f};
        cur = nxt; cA = nA; cB = nB; ++ui;
        if constexpr (ALIGN_EPI) { if (wr == 1) PG8_BAR; }
    }
    PG8_WAIT_V(0);
    if constexpr (!ALIGN_EPI) { if (wr == 0) PG8_BAR; }
    PG8_BAR;
    if constexpr (Epi::AFTER_DRAIN) { E.fused(acc, cur, wr, wc, fr, fq, lds, wid, lane); S.done(cur); }
#undef PG8_SA
#undef PG8_SB
#undef PG8_STAGE
#undef PG8_LDA
#undef PG8_LDB
#undef PG8_MMA
#undef PG8_WAIT_V
#undef PG8_WAIT_L
#undef PG8_BAR
#undef PG8_SCHED
}
}

namespace att {
typedef unsigned short bf16_t;
typedef short bf16x8 __attribute__((ext_vector_type(8)));
typedef float f32x16 __attribute__((ext_vector_type(16)));
typedef unsigned u32x4 __attribute__((ext_vector_type(4)));
typedef unsigned u32x2 __attribute__((ext_vector_type(2)));
typedef float f32x2_t __attribute__((ext_vector_type(2))); typedef __bf16 bf16x2_t __attribute__((ext_vector_type(2)));
__device__ __forceinline__ unsigned cvtpk(float lo, float hi) { f32x2_t v = {lo, hi}; bf16x2_t b = __builtin_convertvector(v, bf16x2_t); return __builtin_bit_cast(unsigned, b); }
__device__ __forceinline__ float swap_max(float v) { auto rr = __builtin_amdgcn_permlane32_swap(__float_as_uint(v), __float_as_uint(v), false, false); return fmaxf(__uint_as_float(rr[0]), __uint_as_float(rr[1])); }
__device__ __forceinline__ float swap_sum(float v) { auto rr = __builtin_amdgcn_permlane32_swap(__float_as_uint(v), __float_as_uint(v), false, false); return __uint_as_float(rr[0]) + __uint_as_float(rr[1]); }

template <int W>
__device__ __forceinline__ void wave_attn(const bf16_t* Qrow0, int qstride, const char* Kt, const char* Vt, int ntiles, int q0, float m_init, float l_init,
                                          f32x16 (&o)[2], float& m_out, float& l_out, int lane) {
    const int r32 = lane & 31, hi = lane >> 5;
    bf16x8 qf[4];
#pragma unroll
    for (int d0 = 0; d0 < 4; ++d0) qf[d0] = *(const bf16x8*)(Qrow0 + (size_t)r32 * qstride + d0 * 16 + hi * 8);
    const int krow = (r32 & 0x13) | ((r32 & 4) << 1) | ((r32 & 8) >> 1);
    int koff[4], voff[4];
#pragma unroll
    for (int i = 0; i < 4; ++i) { koff[i] = img_off(krow, 2 * i + hi); voff[i] = img_off(r32, 2 * i + hi); }
    o[0] = f32x16{}; o[1] = f32x16{};
    float m = m_init, l = hi == 0 ? l_init : 0.0f;
    int jlo = (q0 - W) >> 6; if (jlo < 0) jlo = 0;
    int jhi = (q0 + 31 + W) >> 6; if (jhi > ntiles - 1) jhi = ntiles - 1;
    for (int j = jlo; j <= jhi; ++j) {
        const char* kt = Kt + (size_t)j * 8192; const char* vt = Vt + (size_t)j * 8192;
        bf16x8 k0[4], k1[4];
#pragma unroll
        for (int d0 = 0; d0 < 4; ++d0) { k0[d0] = *(const bf16x8*)(kt + koff[d0]); k1[d0] = *(const bf16x8*)(kt + koff[d0] + 4096); }
        bf16x8 vf[2][4];
#pragma unroll
        for (int db = 0; db < 2; ++db)
#pragma unroll
            for (int s = 0; s < 4; ++s) vf[db][s] = *(const bf16x8*)(vt + voff[s] + db * 4096);
        f32x16 p0 = f32x16{}, p1 = f32x16{};
#pragma unroll
        for (int d0 = 0; d0 < 4; ++d0) { p0 = __builtin_amdgcn_mfma_f32_32x32x16_bf16(k0[d0], qf[d0], p0, 0, 0, 0); p1 = __builtin_amdgcn_mfma_f32_32x32x16_bf16(k1[d0], qf[d0], p1, 0, 0, 0); }
        const bool full = (64 * j >= q0 + 31 - W) && (64 * j + 63 <= q0 + W);
        if (!full) {
            const int dlt = 64 * j + 8 * hi - (q0 + r32);
#pragma unroll
            for (int r = 0; r < 16; ++r) { const int dk = dlt + 16 * (r >> 3) + (r & 7);
                if (dk < -W || dk > W) p0[r] = -INFINITY;
                if (dk + 32 < -W || dk + 32 > W) p1[r] = -INFINITY; }
        }
        float mx = fmaxf(p0[0], p1[0]);
#pragma unroll
        for (int r = 1; r < 16; ++r) mx = fmaxf(mx, fmaxf(p0[r], p1[r]));
        mx = swap_max(mx);
        const float mn = fmaxf(m, mx);
        const float alpha = __builtin_amdgcn_exp2f(m - mn);
        m = mn; l *= alpha;
#pragma unroll
        for (int r = 0; r < 16; ++r) { o[0][r] *= alpha; o[1][r] *= alpha; }
        float s = 0.f;
#pragma unroll
        for (int r = 0; r < 16; ++r) { p0[r] = __builtin_amdgcn_exp2f(p0[r] - mn); p1[r] = __builtin_amdgcn_exp2f(p1[r] - mn); s += p0[r] + p1[r]; }
        l += s;
        u32x4 w0 = {cvtpk(p0[0], p0[1]), cvtpk(p0[2], p0[3]), cvtpk(p0[4], p0[5]), cvtpk(p0[6], p0[7])};
        u32x4 w1 = {cvtpk(p0[8], p0[9]), cvtpk(p0[10], p0[11]), cvtpk(p0[12], p0[13]), cvtpk(p0[14], p0[15])};
        u32x4 w2 = {cvtpk(p1[0], p1[1]), cvtpk(p1[2], p1[3]), cvtpk(p1[4], p1[5]), cvtpk(p1[6], p1[7])};
        u32x4 w3 = {cvtpk(p1[8], p1[9]), cvtpk(p1[10], p1[11]), cvtpk(p1[12], p1[13]), cvtpk(p1[14], p1[15])};
        const bf16x8 b0 = __builtin_bit_cast(bf16x8, w0), b1 = __builtin_bit_cast(bf16x8, w1), b2 = __builtin_bit_cast(bf16x8, w2), b3 = __builtin_bit_cast(bf16x8, w3);
#pragma unroll
        for (int db = 0; db < 2; ++db) {
            o[db] = __builtin_amdgcn_mfma_f32_32x32x16_bf16(vf[db][0], b0, o[db], 0, 0, 0);
            o[db] = __builtin_amdgcn_mfma_f32_32x32x16_bf16(vf[db][1], b1, o[db], 0, 0, 0);
            o[db] = __builtin_amdgcn_mfma_f32_32x32x16_bf16(vf[db][2], b2, o[db], 0, 0, 0);
            o[db] = __builtin_amdgcn_mfma_f32_32x32x16_bf16(vf[db][3], b3, o[db], 0, 0, 0);
        }
    }
    m_out = m; l_out = swap_sum(l);
}
__device__ __forceinline__ void store_o(bf16_t* orow, const f32x16 (&o)[2], float inv, int hi) {
#pragma unroll
    for (int db = 0; db < 2; ++db)
#pragma unroll
        for (int k4 = 0; k4 < 4; ++k4) { u32x2 w; w.x = cvtpk(o[db][4 * k4] * inv, o[db][4 * k4 + 1] * inv); w.y = cvtpk(o[db][4 * k4 + 2] * inv, o[db][4 * k4 + 3] * inv);
            *(u32x2*)(orow + db * 32 + k4 * 8 + hi * 4) = w; }
}
}

constexpr int NWAVES = 8;
constexpr int N_LAUNCHES = MK_N_LAUNCHES;
constexpr int PER_PHASE = 10;
#ifndef MK_CUTS
#define MK_CUTS {0, 10}
#endif
constexpr int CUTS[] = MK_CUTS;
constexpr int N_CUT_LAUNCHES = (int)(sizeof(CUTS) / sizeof(int)) - 1;

constexpr size_t MiB = 1u << 20;
constexpr size_t WS_CTL = 0, CTL_ZERO_BYTES = 1 * MiB;
constexpr size_t WS_ROPE = 1 * MiB;
constexpr size_t WS_W1 = 2 * MiB;
constexpr size_t WS_WV = 12 * MiB;
constexpr size_t WS_WA = 14 * MiB, WS_WB = 16 * MiB, WS_WO = 17 * MiB;
constexpr size_t WS_WGU = 19 * MiB;
constexpr size_t WS_WD = 30 * MiB;
constexpr size_t WS_ST = 36 * MiB;
constexpr size_t WS_XB = 64 * MiB;
constexpr size_t WS_QA = 192 * MiB;
constexpr size_t WS_KA = 320 * MiB, WS_VAT = 352 * MiB;
constexpr size_t WS_QB = 384 * MiB, WS_KB = 480 * MiB, WS_VBT = 576 * MiB;
constexpr size_t WS_GT = 672 * MiB;
constexpr size_t WS_OBG = 928 * MiB;
constexpr size_t WS_T = 192 * MiB;
constexpr size_t WS_END = 1024 * MiB;
static_assert(WS_T + (size_t)MTOK * DFF * 2 <= WS_GT && WS_OBG + (size_t)3 * MTOK * 256 * 2 <= WS_END && WS_WD + (size_t)1024 * DFF * 2 <= WS_ST, "d_ws map");
constexpr int CW_TMO = 0, CW_CODE = 1, CW_BAR = 4096;

constexpr int RING_OFF = 0, RING_BYTES = 131072;
constexpr int LDSCTL_OFF = RING_BYTES, MISC_OFF = LDSCTL_OFF + 320;
constexpr int LDS_BYTES = 147456;

#define GAS __attribute__((address_space(1)))
#define LAS __attribute__((address_space(3)))
typedef unsigned short bf16;
typedef unsigned v4u __attribute__((ext_vector_type(4)));
typedef float f32x4 __attribute__((ext_vector_type(4)));
typedef short bf16x8 __attribute__((ext_vector_type(8)));
typedef GAS unsigned gu32;
typedef GAS unsigned long long gu64;
#define RLX_AGENT __ATOMIC_RELAXED, __HIP_MEMORY_SCOPE_AGENT
#define LDS_WAIT() asm volatile("s_waitcnt lgkmcnt(0)" ::: "memory")
#define VM_WAIT() asm volatile("s_waitcnt vmcnt(0)" ::: "memory")
__device__ __forceinline__ unsigned long long rt() { return __builtin_amdgcn_s_memrealtime(); }
__device__ __forceinline__ unsigned f2bf(float f) { unsigned u = __builtin_bit_cast(unsigned, f); return (u + 0x7fffu + ((u >> 16) & 1u)) >> 16; }
__device__ __forceinline__ unsigned pk2(float lo, float hi) { return f2bf(lo) | (f2bf(hi) << 16); }

#define XB_TMO      128
#define XB_XCNT(j)  (256  + 64 * (j))
#define XB_XSUB(j)  (1280 + 64 * (j))
#define XB_XGEN(j)  (2304 + 64 * (j))
#define XB_TOP      3328
#define XB_TOPGEN   3392
#define XCD_BAR_WORDS 3456
#define XB_SPIN_CAP (1u << 18)

__device__ __forceinline__ unsigned xb_ld(unsigned* p)              { return __hip_atomic_load(p, __ATOMIC_RELAXED, __HIP_MEMORY_SCOPE_AGENT); }
__device__ __forceinline__ unsigned xb_add(unsigned* p, unsigned v) { return __hip_atomic_fetch_add(p, v, __ATOMIC_RELAXED, __HIP_MEMORY_SCOPE_AGENT); }
__device__ __forceinline__ unsigned xb_xcc_id() { return (unsigned)__builtin_amdgcn_s_getreg((3 << 11) | 20) & 0xFu; }
#define XB_SPIN(cond, bar) do { unsigned _sp = 0; while (cond) { __builtin_amdgcn_s_sleep(1); \
    if ((++_sp & 255u) == 0u) { if (xb_ld(&(bar)[XB_TMO])) break; if (_sp > XB_SPIN_CAP) { atomicAdd(&(bar)[XB_TMO], 1u); break; } } } } while (0)

struct XcdBarrier {
    unsigned* bar; unsigned x;
    volatile LAS unsigned* st;
};

__device__ __forceinline__ XcdBarrier xcd_barrier_post(unsigned* bar, volatile LAS unsigned* st) {
    XcdBarrier b; b.bar = bar; b.x = xb_xcc_id(); b.st = st;
    if (threadIdx.x == 0) (void)xb_add(&bar[XB_XCNT(b.x)], 1u);
    return b;
}
__device__ __forceinline__ void xcd_barrier_complete(unsigned* bar, unsigned x, unsigned& nloc, unsigned& nx) {
    const unsigned G = gridDim.x * gridDim.y * gridDim.z;
    unsigned sum, cnt, mine, sp = 0u;
    for (;;) {
        sum = 0u; cnt = 0u; mine = 0u;
#pragma unroll
        for (unsigned j = 0; j < 16; ++j) { const unsigned c = xb_ld(&bar[XB_XCNT(j)]); sum += c; cnt += (c > 0u) ? 1u : 0u; mine = (j == x) ? c : mine; }
        if (sum == G) break;
        __builtin_amdgcn_s_sleep(1);
        if ((++sp & 255u) == 0u) { if (xb_ld(&bar[XB_TMO])) break; if (sp > XB_SPIN_CAP) { atomicAdd(&bar[XB_TMO], 1u); break; } }
    }
    nloc = mine > 0u ? mine : 1u; nx = cnt > 0u ? cnt : 1u;
}

__device__ __forceinline__ void xcd_barrier(const XcdBarrier& b) {
    asm volatile("s_waitcnt vmcnt(0)" ::: "memory");
    __syncthreads();
    if (threadIdx.x == 0) {
        unsigned* bar = b.bar;
        __builtin_amdgcn_s_waitcnt(0);
        unsigned nloc = b.st[0], nx = b.st[1];
        if (nloc == 0u) { xcd_barrier_complete(bar, b.x, nloc, nx); b.st[0] = nloc; b.st[1] = nx; }
        const unsigned old = xb_add(&bar[XB_XSUB(b.x)], 1u);
        const unsigned gen = old / nloc;
        if (old + 1u == (gen + 1u) * nloc) {
            __builtin_amdgcn_fence(__ATOMIC_RELEASE, "agent");
            asm volatile("s_waitcnt vmcnt(0)" ::: "memory");
            const unsigned og = xb_add(&bar[XB_TOP], 1u);
            const unsigned tg = og / nx;
            if (og + 1u == (tg + 1u) * nx) xb_add(&bar[XB_TOPGEN], 1u);
            else XB_SPIN(xb_ld(&bar[XB_TOPGEN]) == tg, bar);
            __builtin_amdgcn_fence(__ATOMIC_ACQUIRE, "agent");
            xb_add(&bar[XB_XGEN(b.x)], 1u);
            asm volatile("s_waitcnt vmcnt(0)" ::: "memory");
        } else {
            XB_SPIN(xb_ld(&bar[XB_XGEN(b.x)]) == gen, bar);
            __builtin_amdgcn_fence(__ATOMIC_ACQUIRE, "agent");
            asm volatile("s_waitcnt vmcnt(0)" ::: "memory");
        }
    }
    __syncthreads();
}

__device__ __forceinline__ void xcc_local_barrier(const XcdBarrier& b) {
    asm volatile("s_waitcnt vmcnt(0)" ::: "memory");
    __syncthreads();
    if (threadIdx.x == 0) {
        unsigned* bar = b.bar;
        __builtin_amdgcn_s_waitcnt(0);
        unsigned nloc = b.st[0], nx = b.st[1];
        if (nloc == 0u) { xcd_barrier_complete(bar, b.x, nloc, nx); b.st[0] = nloc; b.st[1] = nx; }
        const unsigned old = xb_add(&bar[XB_XSUB(b.x)], 1u);
        const unsigned gen = old / nloc;
        if (old + 1u == (gen + 1u) * nloc) xb_add(&bar[XB_XGEN(b.x)], 1u);
        else XB_SPIN(xb_ld(&bar[XB_XGEN(b.x)]) == gen, bar);
        __builtin_amdgcn_fence(__ATOMIC_ACQUIRE, "agent");
        asm volatile("s_waitcnt vmcnt(0)" ::: "memory");
    }
    __syncthreads();
}

struct Frame {
    LAS unsigned char* lds;
    volatile LAS unsigned* MISC;
    gu32* ctl;
    int tid, lane, wave;
    int vcu, G, xcc, rank;
    unsigned char* ws;
};

__device__ __forceinline__ float wave_sum(float v) {
#pragma unroll
    for (int o = 1; o < 64; o <<= 1) v += __shfl_xor(v, o);
    return v;
}
__device__ __forceinline__ void p0_transpose_item(const float* W, int ldw, int K, int c0, int k0, bf16* WT, int drow, LAS float* scr, int lane) {
#pragma unroll 8
    for (int i = 0; i < 32; ++i) { const int kk = 2 * i + (lane >> 5); scr[kk * 33 + (lane & 31)] = W[(size_t)(k0 + kk) * ldw + c0 + (lane & 31)]; }
    LDS_WAIT(); asm volatile("" ::: "memory");
    const int c = lane & 7;
#pragma unroll
    for (int j = 0; j < 4; ++j) { const int n = (lane >> 3) + 8 * j; const LAS float* s = scr + (8 * c) * 33 + n;
        v4u o; o.x = pk2(s[0 * 33], s[1 * 33]); o.y = pk2(s[2 * 33], s[3 * 33]); o.z = pk2(s[4 * 33], s[5 * 33]); o.w = pk2(s[6 * 33], s[7 * 33]);
        *(GAS v4u*)(WT + (size_t)(drow + n) * K + k0 + 8 * c) = o; }
    LDS_WAIT(); asm volatile("" ::: "memory");
}
#define P0_MATRIX(W, ldw, K, N, WTexpr, DROWexpr) if (!done_) { const int nblk = (N) / 32, nit = ((K) / 64) * nblk; \
    if (r < nit) { const int kb = r / nblk, n0 = (r % nblk) * 32; p0_transpose_item((W), (ldw), (K), n0, kb * 64, (WTexpr), (DROWexpr), scr, F.lane); done_ = true; } else r -= nit; }

struct Args { const float* in[15]; float* out; unsigned char* ws; int ph_lo, ph_hi, li, pad; };

__device__ __forceinline__ void p0_prologue(Frame& F, const Args& a) {
    LAS float* scr = (LAS float*)(F.lds + RING_OFF + F.wave * 16384);
    const int gw = F.vcu * NWAVES + F.wave, NGW = F.G * NWAVES;
    bf16* W1 = (bf16*)(F.ws + WS_W1); bf16* WV = (bf16*)(F.ws + WS_WV); bf16* WA = (bf16*)(F.ws + WS_WA); bf16* WB = (bf16*)(F.ws + WS_WB);
    bf16* WO = (bf16*)(F.ws + WS_WO); bf16* WGU = (bf16*)(F.ws + WS_WGU); bf16* WD = (bf16*)(F.ws + WS_WD);
    const float *w_in = a.in[1], *w_gate = a.in[3], *w_br_a = a.in[5], *w_br_b = a.in[6], *w_out = a.in[7], *w_ffg = a.in[10], *w_ffu = a.in[11], *w_ffd = a.in[12];
    constexpr int NITEMS = 16 * 120 + 16 * 64 + 16 * 32 + 4 * 32 + 16 * 32 + 16 * 88 * 2 + 44 * 32;
    for (int it = gw; it < NITEMS; it += NGW) {
        int r = it; bool done_ = false;
        P0_MATRIX(w_in, IN_W, 1024, IN_W, ((n0 >= 1280 && n0 < 1536) || n0 >= 3072) ? WV : W1, n0 < 1280 ? n0 : (n0 < 1536 ? n0 - 1280 : (n0 < 3072 ? n0 - 256 : n0 - 3072 + 256)));
        P0_MATRIX(w_gate, 2048, 1024, 2048, W1, 2816 + n0);
        P0_MATRIX(w_br_a, 1024, 1024, 1024, WA, n0);
        P0_MATRIX(w_br_b, 1024, 256, 1024, WB, n0);
        P0_MATRIX(w_out, 1024, 1024, 1024, WO, n0);
        P0_MATRIX(w_ffg, DFF, 1024, DFF, WGU, 256 * (n0 >> 7) + (n0 & 127));
        P0_MATRIX(w_ffu, DFF, 1024, DFF, WGU, 256 * (n0 >> 7) + 128 + (n0 & 127));
        P0_MATRIX(w_ffd, 1024, DFF, 1024, WD, n0);
    }
    const float* x = a.in[0]; bf16* XB = (bf16*)(F.ws + WS_XB);
    for (int j = F.rank * NWAVES + F.wave; j < SEQ; j += 32 * NWAVES) { const int m = F.xcc * SEQ + j;
        const GAS f32x4* xr = (const GAS f32x4*)(x + (size_t)m * DM) + F.lane;
        GAS unsigned long long* o8 = (GAS unsigned long long*)(XB + (size_t)m * DM) + F.lane;
        f32x4 v[4];
#pragma unroll
        for (int j = 0; j < 4; ++j) v[j] = xr[64 * j];
#pragma unroll
        for (int j = 0; j < 4; ++j) o8[64 * j] = (unsigned long long)pk2(v[j].x, v[j].y) | ((unsigned long long)pk2(v[j].z, v[j].w) << 32);
    }
    float* rope = (float*)(F.ws + WS_ROPE);
    for (int e = F.vcu * 512 + F.tid; e < 8192 * 8; e += F.G * 512) {
        const int pos = e >> 3, i = e & 7;
        const float inv = i == 0 ? 1.0f : i == 1 ? 0.1939227432012558f : i == 2 ? 0.03760603070259094f : i == 3 ? 0.007292664609849453f : i == 4 ? 0.0014142135623842478f
                        : i == 5 ? 0.00027424818836152554f : i == 6 ? 5.318296098266728e-05f : 1.0313386155758053e-05f;
        const float ang = (float)pos * inv;
        const double rev = (double)ang * 0.15915494309189535; const float fr = (float)(rev - __builtin_rint(rev));
        rope[pos * 16 + i] = __builtin_amdgcn_cosf(fr); rope[pos * 16 + 8 + i] = __builtin_amdgcn_sinf(fr);
    }
}

__device__ __forceinline__ void ln_rows(Frame& F, const float* in, const float* gam, const float* bet, float* outf, bf16* outb) {
    f32x4 gv[4], bv[4];
#pragma unroll
    for (int j = 0; j < 4; ++j) { gv[j] = ((const GAS f32x4*)gam)[F.lane + 64 * j]; bv[j] = ((const GAS f32x4*)bet)[F.lane + 64 * j]; }
    for (int j = F.rank * NWAVES + F.wave; j < SEQ; j += 32 * NWAVES) { const int m = F.xcc * SEQ + j;
        const GAS f32x4* xr = (const GAS f32x4*)(in + (size_t)m * DM) + F.lane;
        f32x4 v[4]; float s = 0.f;
#pragma unroll
        for (int j = 0; j < 4; ++j) { v[j] = xr[64 * j]; s += (v[j].x + v[j].y) + (v[j].z + v[j].w); }
        const float mean = wave_sum(s) * (1.f / DM); float s2 = 0.f;
#pragma unroll
        for (int j = 0; j < 4; ++j) { v[j] = v[j] - mean; s2 += (v[j].x * v[j].x + v[j].y * v[j].y) + (v[j].z * v[j].z + v[j].w * v[j].w); }
        const float rstd = 1.f / sqrtf(wave_sum(s2) * (1.f / DM) + LN_EPS);
        GAS f32x4* of = (GAS f32x4*)(outf + (size_t)m * DM) + F.lane;
#pragma unroll
        for (int j = 0; j < 4; ++j) { v[j] = v[j] * rstd * gv[j] + bv[j]; of[64 * j] = v[j]; }
        if (outb) { GAS unsigned long long* o8 = (GAS unsigned long long*)(outb + (size_t)m * DM) + F.lane;
#pragma unroll
            for (int j = 0; j < 4; ++j) o8[64 * j] = (unsigned long long)pk2(v[j].x, v[j].y) | ((unsigned long long)pk2(v[j].z, v[j].w) << 32); }
    }
}

__global__ void __launch_bounds__(NWAVES * 64, 2) skel_fwd(Args args) {
    extern __shared__ __attribute__((aligned(16))) unsigned char lds[];
    Frame F;
    F.lds = (LAS unsigned char*)lds;
    F.MISC = (volatile LAS unsigned*)(F.lds + MISC_OFF);
    F.tid = threadIdx.x; F.lane = F.tid & 63; F.wave = __builtin_amdgcn_readfirstlane(F.tid >> 6);
    F.G = gridDim.x;
    F.ws = args.ws; F.ctl = (gu32*)(args.ws + WS_CTL);
    unsigned char* ws = args.ws;
    for (int u = F.tid; u < (LDS_BYTES - LDSCTL_OFF) / 4; u += NWAVES * 64) ((LAS unsigned*)(F.lds + LDSCTL_OFF))[u] = 0u;
    __syncthreads();
    unsigned* barw = (unsigned*)(F.ctl + CW_BAR) + args.li * XCD_BAR_WORDS;
    if (F.tid == 0) { const unsigned x = xb_xcc_id(); const unsigned r = xb_add(&barw[XB_XCNT(x)], 1u); F.MISC[10] = x; F.MISC[11] = r;
        if (x >= 8u || r >= 32u) __hip_atomic_store(F.ctl + CW_TMO, 0xBAD0u, RLX_AGENT); }
    __syncthreads();
    F.xcc = (int)(F.MISC[10] & 7u); F.rank = (int)(F.MISC[11] & 31u); F.vcu = F.xcc * 32 + F.rank;
    XcdBarrier bar; bar.bar = barw; bar.x = (unsigned)F.xcc; bar.st = F.MISC + 8;
#define GRID_BAR() do { xcd_barrier(bar); } while (0)
#define XCC_BAR() do { xcc_local_barrier(bar); } while (0)
#define REFRESH() do { int t_ = threadIdx.x; asm volatile("" : "+v"(t_)); F.tid = t_; F.lane = t_ & 63; F.wave = __builtin_amdgcn_readfirstlane(t_ >> 6); } while (0)
    const int ph_lo_ = args.ph_lo, ph_hi_ = args.ph_hi;
#define IN(k) (ph_lo_ <= (k) && (k) < ph_hi_)
#define BOTH(k) (IN(k) && IN((k) + 1))
    typedef pg8::bf16_t b16;
    b16* XB = (b16*)(ws + WS_XB); b16* QA = (b16*)(ws + WS_QA); b16* KA = (b16*)(ws + WS_KA); b16* VAT = (b16*)(ws + WS_VAT);
    b16* QB = (b16*)(ws + WS_QB); b16* KB = (b16*)(ws + WS_KB); b16* VBT = (b16*)(ws + WS_VBT); b16* GT = (b16*)(ws + WS_GT);
    b16* OA = XB; b16* OBG = (b16*)(ws + WS_OBG); b16* OB = KA; b16* MX = QA; b16* H1B = XB; b16* TT = (b16*)(ws + WS_T);
    float* ST = (float*)(ws + WS_ST);
    const b16* W1 = (const b16*)(ws + WS_W1); const b16* WV = (const b16*)(ws + WS_WV); const b16* WA = (const b16*)(ws + WS_WA); const b16* WB = (const b16*)(ws + WS_WB);
    const b16* WO = (const b16*)(ws + WS_WO); const b16* WGU = (const b16*)(ws + WS_WGU); const b16* WD = (const b16*)(ws + WS_WD);
    const int G = F.G, bx = F.rank * 8 + F.xcc;

    if (IN(0)) { REFRESH(); p0_prologue(F, args); if (BOTH(0)) GRID_BAR(); }

    if (IN(1)) { REFRESH();
        { pg8::Gemm g{XB, W1, MTOK, 4864, 1024, 1}; pg8::StaticOrder S; S.init(MTOK, 4864, G, bx);
          pg8::EpiProj E{QA, KA, QB, KB, GT, (const float*)(ws + WS_ROPE), args.in[4]};
          pg8::gemm_phase<pg8::EpiProj, pg8::StaticOrder, true, true>(F.lds + RING_OFF, g, S, E); }
        { pg8::Gemm g{WV, XB, 512, MTOK, 1024, 1}; pg8::StaticOrder S; S.init(512, MTOK, G, bx);
          pg8::EpiVT E{{VAT, VBT}, {4, 12}, {0, 0}};
          pg8::gemm_phase<pg8::EpiVT, pg8::StaticOrder, true, true>(F.lds + RING_OFF, g, S, E); }
        { pg8::Gemm g{WV + (size_t)512 * 1024, XB, 256, MTOK, 1024, 4}; pg8::StaticOrder S; S.init(256, MTOK, G, bx);
          pg8::EpiVT E{{VBT, VBT}, {12, 12}, {4, 4}};
          pg8::gemm_phase<pg8::EpiVT, pg8::StaticOrder, true, true>(F.lds + RING_OFF, g, S, E); }
        { pg8::Gemm g{WV + (size_t)768 * 1024, XB, 256, MTOK, 1024, 16}; pg8::StaticOrder S; S.init(256, MTOK, G, bx);
          pg8::EpiVT E{{VBT, VBT}, {12, 12}, {8, 8}};
          pg8::gemm_phase<pg8::EpiVT, pg8::StaticOrder, true, true>(F.lds + RING_OFF, g, S, E); }
        if (BOTH(1)) XCC_BAR();
    }

    if (IN(2)) { REFRESH();
        const int lane = F.lane, w = F.wave, r32 = lane & 31, hi = lane >> 5;
        const float* sink = args.in[2];
        for (int k = 0; k < 16; ++k) {
            const int U = F.vcu * 16 + k, strip = U >> 7, blk = U & 127, b = strip >> 2, kvh = strip & 3;
            const int h = kvh * 4 + (w >> 1), q0 = blk * 64 + 32 * (w & 1);
            att::f32x16 o[2]; float m, l;
            att::wave_attn<128>(QA + (size_t)(b * 8192 + q0) * 1024 + h * 64, 1024, (const char*)(KA + (size_t)strip * 128 * 4096), (const char*)(VAT + (size_t)strip * 128 * 4096),
                                128, q0, sink[h] * LOG2E, 1.0f, o, m, l, lane);
            att::store_o(OA + (size_t)(b * 8192 + q0 + r32) * 1024 + h * 64, o, 1.0f / l, hi);
        }
        for (int k = 0; k < 12; ++k) {
            const int U = F.vcu * 12 + k, blk = U & 31, hs = (U >> 5) & 3, bg = U >> 7, g = bg % 3, b = bg / 3;
            const int p0 = blk * 256 + 32 * w;
            const int L = g == 0 ? 8192 : (g == 1 ? 2048 : 512), seq = p0 / L, q0 = p0 % L;
            const size_t tile0 = (size_t)(((b * 3 + g) * 4 + hs) * 128 + seq * (L >> 6));
            att::f32x16 o[2]; float m, l;
            att::wave_attn<64>(QB + (size_t)(b * 8192 + p0) * 768 + g * 256 + hs * 64, 768, (const char*)(KB + tile0 * 4096), (const char*)(VBT + tile0 * 4096),
                               L >> 6, q0, -1e30f, 0.0f, o, m, l, lane);
            const int pq = q0 + r32, t = g == 0 ? pq : (g == 1 ? pq * 4 + seq : pq * 16 + seq);
            const size_t tok = (size_t)b * 8192 + t;
            att::store_o(OBG + ((size_t)g * MTOK + tok) * 256 + hs * 64, o, 1.0f / l, hi);
            if (hi == 0) { typedef float f32x2v __attribute__((ext_vector_type(2))); *(f32x2v*)(ST + (((size_t)g * MTOK + tok) * 4 + hs) * 2) = (f32x2v){m, l}; }
        }
        if (BOTH(2)) XCC_BAR();
    }

    if (IN(3)) { REFRESH();
        for (int il = F.rank * 512 + F.tid; il < SEQ * 32; il += 32 * 512) {
            const size_t tok = (size_t)F.xcc * SEQ + (il >> 5); const int hs = (il >> 3) & 3, dc = il & 7;
            float mg[3], lg[3];
#pragma unroll
            for (int g = 0; g < 3; ++g) { const unsigned long long w_ = __hip_atomic_load((const gu64*)(ST + (((size_t)g * MTOK + tok) * 4 + hs) * 2), RLX_AGENT); mg[g] = __uint_as_float((unsigned)w_); lg[g] = __uint_as_float((unsigned)(w_ >> 32)); }
            const float M = fmaxf(mg[0], fmaxf(mg[1], mg[2]));
            float wg[3], ws_ = 0.f;
#pragma unroll
            for (int g = 0; g < 3; ++g) { wg[g] = lg[g] * __builtin_amdgcn_exp2f(mg[g] - M); ws_ += wg[g]; }
            const float inv = 1.0f / ws_;
            float acc[8] = {0.f, 0.f, 0.f, 0.f, 0.f, 0.f, 0.f, 0.f};
#pragma unroll
            for (int g = 0; g < 3; ++g) { const gu64* op_ = (const gu64*)(OBG + ((size_t)g * MTOK + tok) * 256 + hs * 64 + dc * 8); const unsigned long long a_ = __hip_atomic_load(op_, RLX_AGENT), b_ = __hip_atomic_load(op_ + 1, RLX_AGENT);
                v4u v; v.x = (unsigned)a_; v.y = (unsigned)(a_ >> 32); v.z = (unsigned)b_; v.w = (unsigned)(b_ >> 32); const float wq = wg[g] * inv;
                acc[0] += wq * pg8::bf_lo(v.x); acc[1] += wq * pg8::bf_hi(v.x); acc[2] += wq * pg8::bf_lo(v.y); acc[3] += wq * pg8::bf_hi(v.y);
                acc[4] += wq * pg8::bf_lo(v.z); acc[5] += wq * pg8::bf_hi(v.z); acc[6] += wq * pg8::bf_lo(v.w); acc[7] += wq * pg8::bf_hi(v.w); }
            v4u o; o.x = pk2(acc[0], acc[1]); o.y = pk2(acc[2], acc[3]); o.z = pk2(acc[4], acc[5]); o.w = pk2(acc[6], acc[7]);
            *(v4u*)(OB + tok * 256 + hs * 64 + dc * 8) = o;
        }
        if (BOTH(3)) XCC_BAR();
    }

    if (IN(4)) { REFRESH();
        { pg8::Gemm g{OB, WB, MTOK, 1024, 256, 1}; pg8::StaticOrder S; S.init(MTOK, 1024, G, bx);
          pg8::EpiGate<true> E{MX, GT, 1024};
          pg8::gemm_phase<pg8::EpiGate<true>, pg8::StaticOrder, true, true>(F.lds + RING_OFF, g, S, E); }
        { pg8::Gemm g{OA, WA, MTOK, 1024, 1024, 1}; pg8::StaticOrder S; S.init(MTOK, 1024, G, bx);
          pg8::EpiGate<false> E{MX, GT, 0};
          pg8::gemm_phase<pg8::EpiGate<false>, pg8::StaticOrder, true, true>(F.lds + RING_OFF, g, S, E); }
        if (BOTH(4)) XCC_BAR();
    }

    if (IN(5)) { REFRESH();
        pg8::Gemm g{MX, WO, MTOK, 1024, 1024, 1}; pg8::StaticOrder S; S.init(MTOK, 1024, G, bx);
        pg8::EpiRes E{args.in[0], args.out, 1};
        pg8::gemm_phase<pg8::EpiRes, pg8::StaticOrder, true, true>(F.lds + RING_OFF, g, S, E);
        if (BOTH(5)) XCC_BAR();
    }
    if (IN(6)) { REFRESH(); ln_rows(F, args.out, args.in[8], args.in[9], args.out, (bf16*)H1B); if (BOTH(6)) XCC_BAR(); }

    if (IN(7)) { REFRESH();
        pg8::Gemm g{H1B, WGU, MTOK, 5632, 1024, 1}; pg8::StaticOrder S; S.init(MTOK, 5632, G, bx);
        pg8::EpiSwiGLU E{TT};
        pg8::gemm_phase<pg8::EpiSwiGLU, pg8::StaticOrder, true, true>(F.lds + RING_OFF, g, S, E);
        if (BOTH(7)) XCC_BAR();
    }
    if (IN(8)) { REFRESH();
        pg8::Gemm g{TT, WD, MTOK, 1024, DFF, 1}; pg8::StaticOrder S; S.init(MTOK, 1024, G, bx);
        pg8::EpiRes E{args.out, args.out, 0};
        pg8::gemm_phase<pg8::EpiRes, pg8::StaticOrder, true, true>(F.lds + RING_OFF, g, S, E);
        if (BOTH(8)) XCC_BAR();
    }
    if (IN(9)) { REFRESH();
        const bool bad = __hip_atomic_load(F.ctl + CW_TMO, RLX_AGENT) != 0u || __hip_atomic_load((gu32*)(barw + XB_TMO), RLX_AGENT) != 0u;
        if (bad) { const float qn = __builtin_nanf("");
            for (int j = F.rank * NWAVES + F.wave; j < SEQ; j += 32 * NWAVES) { GAS f32x4* o = (GAS f32x4*)(args.out + (size_t)(F.xcc * SEQ + j) * DM) + F.lane;
#pragma unroll
                for (int q = 0; q < 4; ++q) o[64 * q] = (f32x4){qn, qn, qn, qn}; } }
        else ln_rows(F, args.out, args.in[13], args.in[14], args.out, nullptr);
    }
#undef IN
#undef BOTH
}

extern "C" void kernel_launch(void* const* d_in, const int* in_sizes, int n_in, void* d_out, int out_size, void* d_ws, size_t ws_size, hipStream_t stream) {
    static int grid = 0;
    if (grid == 0) {
        if (n_in != 15 || in_sizes[0] != MTOK * DM || out_size != MTOK * DM || ws_size < WS_END) {
            fprintf(stderr, "kernel_launch: unexpected problem: n_in %d in0 %d out %d ws %zu (need %zu); nothing launched\n", n_in, n_in > 0 ? in_sizes[0] : -1, out_size, ws_size, (size_t)WS_END); grid = -1; return; }
        int dev = 0, cus = 0, per_cu = 0;
        if (hipGetDevice(&dev) != hipSuccess || hipDeviceGetAttribute(&cus, hipDeviceAttributeMultiprocessorCount, dev) != hipSuccess) { fprintf(stderr, "kernel_launch: device query failed\n"); grid = -1; return; }
        if (hipFuncSetAttribute((const void*)skel_fwd, hipFuncAttributeMaxDynamicSharedMemorySize, LDS_BYTES) != hipSuccess) { fprintf(stderr, "kernel_launch: hipFuncSetAttribute failed\n"); grid = -1; return; }
        if (hipOccupancyMaxActiveBlocksPerMultiprocessor(&per_cu, (const void*)skel_fwd, NWAVES * 64, LDS_BYTES) != hipSuccess || per_cu < 1)
            fprintf(stderr, "kernel_launch: note: occupancy query reports %d workgroups per CU\n", per_cu);
        (void)hipGetLastError();
        grid = cus;
        if (grid != 256) fprintf(stderr, "kernel_launch: note: %d CUs (built for 256)\n", grid);
    }
    if (grid < 0) return;
    if (hipMemsetAsync((char*)d_ws + WS_CTL, 0, CTL_ZERO_BYTES, stream) != hipSuccess) { fprintf(stderr, "kernel_launch: memset failed\n"); return; }
    Args a{};
    for (int i = 0; i < 15; ++i) a.in[i] = (const float*)d_in[i];
    a.out = (float*)d_out; a.ws = (unsigned char*)d_ws;
    for (int li = 0; li < N_CUT_LAUNCHES; ++li) {
        a.ph_lo = CUTS[li]; a.ph_hi = CUTS[li + 1]; a.li = li;
        hipLaunchKernelGGL(skel_fwd, dim3(grid), dim3(NWAVES * 64), LDS_BYTES, stream, a);
        const hipError_t le = hipPeekAtLastError();
        if (le != hipSuccess) { fprintf(stderr, "kernel_launch: launch %d failed: %s\n", li, hipGetErrorName(le)); break; }
    }
}
```

```cpp
#include <hip/hip_runtime.h>
#include <cstdio>
#include <cstdint>

#ifndef MK_N_LAUNCHES
#define MK_N_LAUNCHES 1
#endif

constexpr int BATCH = 8, SEQ = 8192, DM = 1024, MTOK = BATCH * SEQ;
constexpr int IN_W = 3840, DFF = 2816;
constexpr float LN_EPS = 1e-5f, DN_ALPHA = 1.189207115002721f;
constexpr float QSCALE = 0.18033688011112042f;
constexpr float LOG2E = 1.4426950408889634f;

__host__ __device__ __forceinline__ int img_off(int rho, int c) { return (rho >> 1) * 256 + (((((rho & 1) << 3) | c) ^ ((rho >> 1) & 7)) << 4); }

namespace pg8 {
#define PG8_LAS __attribute__((address_space(3)))
typedef unsigned short bf16_t;
typedef short bf16x8 __attribute__((ext_vector_type(8)));
typedef float f32x4 __attribute__((ext_vector_type(4)));
typedef unsigned u32x4 __attribute__((ext_vector_type(4)));
typedef unsigned u32x2 __attribute__((ext_vector_type(2)));
constexpr int BM = 256, BK = 64, HALF = 128, HTB = HALF * BK * 2  , STAGE_BYTES = 8 * HTB, NXCD = 8, WGM = 8;

__host__ __device__ __forceinline__ int lds_byte(int r, int c) { const int st = (r >> 4) * 2 + (c >> 5), rr = r & 15, cc = c & 31, ob = rr * 64 + cc * 2; return st * 1024 + (ob ^ (((ob >> 9) & 1) << 5)); }
__host__ __device__ __forceinline__ void stage_rc(int b, int& R, int& C) { const int st = b / 1024, sb = b % 1024, swz = sb ^ (((sb >> 9) & 1) << 5); R = (st >> 1) * 16 + swz / 64; C = (st & 1) * 32 + (swz % 64) / 2; }
__host__ __device__ __forceinline__ int perm32(int rho) { const int n = rho >> 4, i = rho & 15; return 8 * (i >> 2) + 4 * n + (i & 3); }

struct Unit { int pm, pn; };
struct Gemm { const bf16_t* A; const bf16_t* Bt; int M, N, K; int bmul; };

__device__ __forceinline__ size_t b_unit_off(const Gemm& g, int pn) {
    if (g.bmul == 1) return (size_t)pn * 256 * (size_t)g.K * 2;
    const int P0 = pn * 256, b = P0 >> 13, p = P0 & 8191, L = 8192 / g.bmul, seq = p / L, pos = p % L;
    return (size_t)(b * 8192 + pos * g.bmul + seq) * (size_t)g.K * 2;
}

struct StaticOrder {
    int nM, nN, nwg, G, c;
    __host__ __device__ void init(int M, int N, int G_, int c_) { nM = M / BM; nN = N / BM; nwg = nM * nN; G = G_; c = c_; }
    __host__ __device__ bool next(int i, Unit& u) const {
        const long L = (long)i * G + c; if (L >= nwg) return false;
        int wgid = (int)L; { const int q = nwg / NXCD, r = nwg % NXCD, xcd = wgid % NXCD, off = wgid / NXCD; wgid = (xcd < r ? xcd * (q + 1) : r * (q + 1) + (xcd - r) * q) + off; }
        const int nig = WGM * nN, gid = wgid / nig, fm = gid * WGM, gsz = (nM - fm) < WGM ? (nM - fm) : WGM;
        u.pm = fm + ((wgid % nig) % gsz); u.pn = (wgid % nig) / gsz; return true;
    }
    __device__ __forceinline__ void a_ready(const Unit&) const {}
    __device__ __forceinline__ void done(const Unit&) const {}
};

typedef float f32x2_t __attribute__((ext_vector_type(2))); typedef __bf16 bf16x2_t __attribute__((ext_vector_type(2)));
__device__ __forceinline__ unsigned cvt_pk_bf16(float lo, float hi) { f32x2_t v = {lo, hi}; bf16x2_t b = __builtin_convertvector(v, bf16x2_t); return __builtin_bit_cast(unsigned, b); }
__device__ __forceinline__ float bf_lo(unsigned w) { return __uint_as_float(w << 16); }
__device__ __forceinline__ float bf_hi(unsigned w) { return __uint_as_float(w & 0xffff0000u); }
__device__ __forceinline__ float sigmoidf_(float z) { return __builtin_amdgcn_rcpf(1.0f + __builtin_amdgcn_exp2f(-z * LOG2E)); }
__device__ __forceinline__ u32x4 pack8(const f32x4 a, const f32x4 b) { u32x4 w; w.x = cvt_pk_bf16(a[0], a[1]); w.y = cvt_pk_bf16(a[2], a[3]); w.z = cvt_pk_bf16(b[0], b[1]); w.w = cvt_pk_bf16(b[2], b[3]); return w; }


struct EpiProj {
    static constexpr bool PERM = true, AFTER_DRAIN = false;
    bf16_t *QA, *KA, *QB, *KB, *GT; const float* rope; const float* bgate;
    __device__ __forceinline__ void operator()(const f32x4 (&acc)[2][2][4][2], const Unit& u, int wr, int wc, int fr, int fq) const {
        const int pn = u.pn, row0 = u.pm * BM + wr * 64 + fr;
        if (pn >= 11) {
            const int col0 = (pn - 11) * 256 + wc * 32 + 8 * fq;
            f32x4 bv[2][2];
#pragma unroll
            for (int bj = 0; bj < 2; ++bj)
#pragma unroll
                for (int n = 0; n < 2; ++n) bv[bj][n] = *(const f32x4*)(bgate + col0 + bj * HALF + 4 * n);
#pragma unroll
            for (int ai = 0; ai < 2; ++ai)
#pragma unroll
                for (int m = 0; m < 4; ++m) { bf16_t* rowp = GT + (size_t)(row0 + ai * HALF + m * 16) * 2048 + col0;
#pragma unroll
                    for (int bj = 0; bj < 2; ++bj) { f32x4 v0 = acc[ai][bj][m][0] + bv[bj][0], v1 = acc[ai][bj][m][1] + bv[bj][1];
#pragma unroll
                        for (int e = 0; e < 4; ++e) { v0[e] = sigmoidf_(v0[e]); v1[e] = sigmoidf_(v1[e]); }
                        *(u32x4*)(rowp + bj * HALF) = pack8(v0, v1); } }
            return;
        }
        const int typ = pn < 4 ? 0 : (pn == 4 ? 1 : (pn < 8 ? 2 : 3));
        const int grp = typ == 2 ? pn - 5 : (typ == 3 ? pn - 8 : 0);
        const float sc = (typ == 0 || typ == 2) ? QSCALE : 1.0f;
        const bool rot_wave = (wc & 1) == 0, rot_lane = fq < 2;
        const float sgn = fq == 0 ? -1.0f : 1.0f;
        const int chunk = 4 * (wc & 1) + fq;
#pragma unroll
        for (int ai = 0; ai < 2; ++ai)
#pragma unroll
            for (int m = 0; m < 4; ++m) {
                const int tg = row0 + ai * HALF + m * 16, b = tg >> 13, t = tg & 8191;
                f32x4 c0 = {1.f, 1.f, 1.f, 1.f}, c1 = c0, s0 = {0.f, 0.f, 0.f, 0.f}, s1 = s0;
                if (rot_wave && rot_lane) { const f32x4* rp = (const f32x4*)(rope + (size_t)t * 16); c0 = rp[0]; c1 = rp[1]; s0 = rp[2] * sgn; s1 = rp[3] * sgn; }
                const int p = grp == 0 ? t : (grp == 1 ? ((t & 3) * 2048 + (t >> 2)) : ((t & 15) * 512 + (t >> 4)));
#pragma unroll
                for (int bj = 0; bj < 2; ++bj) {
                    f32x4 v0 = acc[ai][bj][m][0], v1 = acc[ai][bj][m][1];
                    if (rot_wave) {
                        f32x4 q0, q1;
#pragma unroll
                        for (int e = 0; e < 4; ++e) { q0[e] = __shfl_xor(v0[e], 16); q1[e] = __shfl_xor(v1[e], 16); }
                        v0 = v0 * c0 + q0 * s0; v1 = v1 * c1 + q1 * s1;
                    }
                    v0 = v0 * sc; v1 = v1 * sc;
                    const int cl = bj * HALF + wc * 32 + 8 * fq, hh = 2 * bj + (wc >> 1);
                    bf16_t* dst;
                    if (typ == 0)      dst = QA + (size_t)tg * 1024 + pn * 256 + cl;
                    else if (typ == 1) dst = KA + ((size_t)((b * 4 + hh) * 128 + (t >> 6))) * 4096 + (img_off(t & 63, chunk) >> 1);
                    else if (typ == 2) dst = QB + (size_t)(b * 8192 + p) * 768 + grp * 256 + cl;
                    else               dst = KB + ((size_t)(((b * 3 + grp) * 4 + hh) * 128 + (p >> 6))) * 4096 + (img_off(p & 63, chunk) >> 1);
                    *(u32x4*)dst = pack8(v0, v1);
                }
            }
    }
};
struct EpiVT {
    static constexpr bool PERM = true, AFTER_DRAIN = false;
    bf16_t* dst[2]; int nhb[2], hoff[2];
    __device__ __forceinline__ void operator()(const f32x4 (&acc)[2][2][4][2], const Unit& u, int wr, int wc, int fr, int fq) const {
        bf16_t* base = u.pm == 0 ? dst[0] : dst[1]; const int nh = u.pm == 0 ? nhb[0] : nhb[1], ho = u.pm == 0 ? hoff[0] : hoff[1];
        const int P0 = u.pn * BM, b = P0 >> 13, j0 = (P0 & 8191) >> 6, chunk = 4 * (wc & 1) + fq;
#pragma unroll
        for (int ai = 0; ai < 2; ++ai)
#pragma unroll
            for (int m = 0; m < 4; ++m) { const int hh = 2 * ai + wr, d = m * 16 + fr;
#pragma unroll
                for (int bj = 0; bj < 2; ++bj) { const int j = j0 + 2 * bj + (wc >> 1);
                    bf16_t* p = base + ((size_t)((b * nh + ho + hh) * 128 + j)) * 4096 + (img_off(d, chunk) >> 1);
                    *(u32x4*)p = pack8(acc[ai][bj][m][0], acc[ai][bj][m][1]); } }
    }
};
template <bool FIRST> struct EpiGate {
    static constexpr bool PERM = true, AFTER_DRAIN = false;
    bf16_t* MX; const bf16_t* GT; int goff;
    __device__ __forceinline__ void operator()(const f32x4 (&acc)[2][2][4][2], const Unit& u, int wr, int wc, int fr, int fq) const {
        const int row0 = u.pm * BM + wr * 64 + fr, col0 = u.pn * BM + wc * 32 + 8 * fq;
#pragma unroll
        for (int ai = 0; ai < 2; ++ai)
#pragma unroll
            for (int m = 0; m < 4; ++m) { const size_t r = (size_t)(row0 + ai * HALF + m * 16);
#pragma unroll
                for (int bj = 0; bj < 2; ++bj) {
                    const u32x4 gw = *(const u32x4*)(GT + r * 2048 + goff + col0 + bj * HALF);
                    f32x4 v0 = acc[ai][bj][m][0], v1 = acc[ai][bj][m][1];
                    v0[0] *= bf_lo(gw.x); v0[1] *= bf_hi(gw.x); v0[2] *= bf_lo(gw.y); v0[3] *= bf_hi(gw.y);
                    v1[0] *= bf_lo(gw.z); v1[1] *= bf_hi(gw.z); v1[2] *= bf_lo(gw.w); v1[3] *= bf_hi(gw.w);
                    bf16_t* dp = MX + r * 1024 + col0 + bj * HALF;
                    if (!FIRST) { const u32x4 ow = *(const u32x4*)dp;
                        v0[0] += bf_lo(ow.x); v0[1] += bf_hi(ow.x); v0[2] += bf_lo(ow.y); v0[3] += bf_hi(ow.y);
                        v1[0] += bf_lo(ow.z); v1[1] += bf_hi(ow.z); v1[2] += bf_lo(ow.w); v1[3] += bf_hi(ow.w); }
                    *(u32x4*)dp = pack8(v0, v1); } }
    }
};
struct EpiRes {
    static constexpr bool PERM = false, AFTER_DRAIN = false;
    const float* base; float* out; int noy;
    __device__ __forceinline__ void operator()(const f32x4 (&acc)[2][2][4][2], const Unit& u, int wr, int wc, int fr, int fq) const {
        const int row0 = u.pm * BM + wr * 64 + fr, col0 = u.pn * BM + wc * 32 + 4 * fq;
#pragma unroll
        for (int ai = 0; ai < 2; ++ai)
#pragma unroll
            for (int m = 0; m < 4; ++m) { const size_t off = (size_t)(row0 + ai * HALF + m * 16) * 1024 + col0;
#pragma unroll
                for (int bj = 0; bj < 2; ++bj)
#pragma unroll
                    for (int n = 0; n < 2; ++n) { const f32x4 bs = *(const f32x4*)(base + off + bj * HALF + n * 16);
#ifdef DBG_NOY
                        *(f32x4*)(out + off + bj * HALF + n * 16) = bs * DN_ALPHA + (noy ? acc[ai][bj][m][n] * 0.0f : acc[ai][bj][m][n]); } }
#else
                        *(f32x4*)(out + off + bj * HALF + n * 16) = bs * DN_ALPHA + acc[ai][bj][m][n]; } }
#endif
    }
};
struct EpiSwiGLU {
    static constexpr bool PERM = true, AFTER_DRAIN = false;
    bf16_t* T;
    __device__ __forceinline__ void operator()(const f32x4 (&acc)[2][2][4][2], const Unit& u, int wr, int wc, int fr, int fq) const {
        const int row0 = u.pm * BM + wr * 64 + fr, col0 = u.pn * HALF + wc * 32 + 8 * fq;
#pragma unroll
        for (int ai = 0; ai < 2; ++ai)
#pragma unroll
            for (int m = 0; m < 4; ++m) { f32x4 v0, v1;
#pragma unroll
                for (int e = 0; e < 4; ++e) { const float g0 = acc[ai][0][m][0][e], g1 = acc[ai][0][m][1][e];
                    v0[e] = g0 * sigmoidf_(g0) * acc[ai][1][m][0][e]; v1[e] = g1 * sigmoidf_(g1) * acc[ai][1][m][1][e]; }
                *(u32x4*)(T + (size_t)(row0 + ai * HALF + m * 16) * DFF + col0) = pack8(v0, v1); }
    }
};

template <class Epi, class Sched, bool ALIGN_EPI = false, bool SP2 = false>
__device__ __forceinline__ void gemm_phase(PG8_LAS unsigned char* lds, const Gemm g, const Sched& S, const Epi& E) {
    int tid_ = threadIdx.x; asm volatile("" : "+v"(tid_));
    const int tid = tid_, wid = __builtin_amdgcn_readfirstlane(tid >> 6), lane = tid & 63, wr = wid >> 2, wc = wid & 3, fr = lane & 15, fq = lane >> 4;
    const int K = g.K, nt = K / BK;
    unsigned voffA[2], voffB[2];
#pragma unroll
    for (int i = 0; i < 2; ++i) { int R, C; stage_rc(tid * 16 + i * 8192, R, C); const int Rb = Epi::PERM ? ((R & ~31) + perm32(R & 31)) : R;
        voffA[i] = (unsigned)(R * K + C) * 2u; voffB[i] = (unsigned)(Rb * K * g.bmul + C) * 2u; }
    const size_t kstep = (size_t)(BK * 2);
    const size_t hstep = (size_t)HALF * K * 2;
    const size_t tstep = 2 * hstep;   const size_t hstepB = hstep * (size_t)g.bmul;
    const unsigned ldsw = (unsigned)wid * 1024u;
    const int aoff = lds_byte(wr * 64 + fr, fq * 8), boff = lds_byte(wc * 32 + fr, fq * 8);
#define PG8_SA(b, h) (((b) * 2 + (h)) * HTB)
#define PG8_SB(b, h) ((4 + (b) * 2 + (h)) * HTB)
#define PG8_STAGE(bufoff, gbase, voff) do { _Pragma("unroll") for (int _i = 0; _i < 2; ++_i) \
        __builtin_amdgcn_global_load_lds((const unsigned*)((const char*)(gbase) + (voff)[_i]), (PG8_LAS unsigned*)(lds + (bufoff) + ldsw + _i * 8192), 16, 0, 0); } while (0)
#define PG8_LDA(dst, b, h) do { _Pragma("unroll") for (int m = 0; m < 4; ++m) _Pragma("unroll") for (int k = 0; k < 2; ++k) dst[m][k] = *(const PG8_LAS bf16x8*)(lds + PG8_SA(b, h) + aoff + m * 2048 + k * 1024); } while (0)
#define PG8_LDB(dst, b, h) do { _Pragma("unroll") for (int n = 0; n < 2; ++n) _Pragma("unroll") for (int k = 0; k < 2; ++k) dst[n][k] = *(const PG8_LAS bf16x8*)(lds + PG8_SB(b, h) + boff + n * 2048 + k * 1024); } while (0)
#define PG8_MMA(ai, bj, At, Bt) do { __builtin_amdgcn_s_setprio(1); _Pragma("unroll") for (int m = 0; m < 4; ++m) _Pragma("unroll") for (int n = 0; n < 2; ++n) _Pragma("unroll") for (int k = 0; k < 2; ++k) \
        acc[ai][bj][m][n] = __builtin_amdgcn_mfma_f32_16x16x32_bf16(Bt[n][k], At[m][k], acc[ai][bj][m][n], 0, 0, 0); __builtin_amdgcn_s_setprio(0); } while (0)
#define PG8_WAIT_V(n) asm volatile("s_waitcnt vmcnt(" #n ")" ::: "memory")
#define PG8_WAIT_L(n) asm volatile("s_waitcnt lgkmcnt(" #n ")" ::: "memory")
#define PG8_BAR __builtin_amdgcn_s_barrier()
#define PG8_SCHED __builtin_amdgcn_sched_barrier(0)
    Unit cur, nxt; int ui = 0;
    if (!S.next(0, cur)) return;
    f32x4 acc[2][2][4][2];
#pragma unroll
    for (int a = 0; a < 2; ++a)
#pragma unroll
        for (int b = 0; b < 2; ++b)
#pragma unroll
            for (int m = 0; m < 4; ++m)
#pragma unroll
                for (int n = 0; n < 2; ++n) acc[a][b][m][n] = (f32x4){0.f, 0.f, 0.f, 0.f};
    bf16x8 At[4][2], B0[2][2], B1[2][2];
    const char* cA = (const char*)g.A + (size_t)cur.pm * tstep; const char* cB = (const char*)g.Bt + b_unit_off(g, cur.pn);
    S.a_ready(cur);
    if constexpr (SP2) {
        PG8_STAGE(PG8_SB(0, 0), cB, voffB); PG8_STAGE(PG8_SB(0, 1), cB + hstepB, voffB); PG8_STAGE(PG8_SA(0, 0), cA, voffA); PG8_STAGE(PG8_SA(0, 1), cA + hstep, voffA);
        if (wr == 1) PG8_BAR;
        PG8_WAIT_V(2); PG8_BAR;
        PG8_STAGE(PG8_SB(1, 0), cB + kstep, voffB); PG8_STAGE(PG8_SA(1, 0), cA + kstep, voffA); PG8_STAGE(PG8_SB(1, 1), cB + hstepB + kstep, voffB);
        PG8_WAIT_V(6); PG8_BAR;
    } else {
        PG8_STAGE(PG8_SB(0, 0), cB, voffB); PG8_STAGE(PG8_SA(0, 0), cA, voffA); PG8_STAGE(PG8_SB(0, 1), cB + hstepB, voffB); PG8_STAGE(PG8_SA(0, 1), cA + hstep, voffA);
        if (wr == 1) PG8_BAR;
        PG8_WAIT_V(4); PG8_BAR;
        PG8_STAGE(PG8_SB(1, 0), cB + kstep, voffB); PG8_STAGE(PG8_SA(1, 0), cA + kstep, voffA); PG8_STAGE(PG8_SB(1, 1), cB + hstepB + kstep, voffB);
        PG8_WAIT_V(6); PG8_BAR;
    }
    for (;;) {
        const bool has_next = S.next(ui + 1, nxt);
        const char* nA = has_next ? (const char*)g.A + (size_t)nxt.pm * tstep : cA; const char* nB = has_next ? (const char*)g.Bt + b_unit_off(g, nxt.pn) : cB;
        for (int t = 0; t < nt; t += 2) {
            const bool last = (t == nt - 2);
            const char* a1 = cA + (size_t)(t + 1) * kstep;
            const char* a2 = last ? nA : cA + (size_t)(t + 2) * kstep; const char* b2 = last ? nB : cB + (size_t)(t + 2) * kstep;
            const char* a3 = a2 + kstep; const char* b3 = b2 + kstep;
            if (last && has_next) S.a_ready(nxt);
            if constexpr (SP2) {
            PG8_LDB(B0, 0, 0); PG8_LDB(B1, 0, 1); PG8_SCHED; PG8_LDA(At, 0, 0); PG8_STAGE(PG8_SA(1, 1), a1 + hstep, voffA);
            PG8_WAIT_V(8); PG8_WAIT_L(0); PG8_BAR; PG8_MMA(0, 0, At, B0); PG8_MMA(0, 1, At, B1); PG8_BAR; PG8_SCHED;
            PG8_LDA(At, 0, 1); PG8_STAGE(PG8_SB(0, 0), b2, voffB); PG8_STAGE(PG8_SB(0, 1), b2 + hstepB, voffB); PG8_STAGE(PG8_SA(0, 0), a2, voffA);
            PG8_WAIT_V(8); PG8_WAIT_L(0); PG8_BAR; PG8_MMA(1, 0, At, B0); PG8_MMA(1, 1, At, B1); PG8_BAR; PG8_SCHED;
            PG8_LDB(B0, 1, 0); PG8_LDB(B1, 1, 1); PG8_SCHED; PG8_LDA(At, 1, 0); PG8_STAGE(PG8_SA(0, 1), a2 + hstep, voffA);
            PG8_WAIT_V(8); PG8_WAIT_L(0); PG8_BAR; PG8_MMA(0, 0, At, B0); PG8_MMA(0, 1, At, B1); PG8_BAR; PG8_SCHED;
            PG8_LDA(At, 1, 1); PG8_STAGE(PG8_SB(1, 0), b3, voffB); PG8_STAGE(PG8_SB(1, 1), b3 + hstepB, voffB); PG8_STAGE(PG8_SA(1, 0), a3, voffA);
            PG8_WAIT_V(8); PG8_WAIT_L(0); PG8_BAR; PG8_MMA(1, 0, At, B0); PG8_MMA(1, 1, At, B1); PG8_BAR; PG8_SCHED;
            } else {
            PG8_LDB(B0, 0, 0); PG8_SCHED; PG8_LDA(At, 0, 0); PG8_STAGE(PG8_SA(1, 1), a1 + hstep, voffA);
            PG8_WAIT_L(8); PG8_BAR; PG8_WAIT_L(0); PG8_MMA(0, 0, At, B0); PG8_BAR; PG8_SCHED;
            PG8_LDB(B1, 0, 1); PG8_STAGE(PG8_SB(0, 0), b2, voffB);
            PG8_BAR; PG8_WAIT_L(0); PG8_MMA(0, 1, At, B1); PG8_BAR;
            PG8_LDA(At, 0, 1); PG8_STAGE(PG8_SA(0, 0), a2, voffA);
            PG8_BAR; PG8_WAIT_L(0); PG8_MMA(1, 0, At, B0); PG8_BAR; PG8_SCHED;
            PG8_STAGE(PG8_SB(0, 1), b2 + hstepB, voffB);
            PG8_WAIT_V(6); PG8_BAR; PG8_MMA(1, 1, At, B1); PG8_BAR;
            PG8_LDB(B0, 1, 0); PG8_SCHED; PG8_LDA(At, 1, 0); PG8_STAGE(PG8_SA(0, 1), a2 + hstep, voffA);
            PG8_WAIT_L(8); PG8_BAR; PG8_WAIT_L(0); PG8_MMA(0, 0, At, B0); PG8_BAR; PG8_SCHED;
            PG8_LDB(B1, 1, 1); PG8_STAGE(PG8_SB(1, 0), b3, voffB);
            PG8_BAR; PG8_WAIT_L(0); PG8_MMA(0, 1, At, B1); PG8_BAR;
            PG8_LDA(At, 1, 1); PG8_STAGE(PG8_SA(1, 0), a3, voffA);
            PG8_BAR; PG8_WAIT_L(0); PG8_MMA(1, 0, At, B0); PG8_BAR; PG8_SCHED;
            PG8_STAGE(PG8_SB(1, 1), b3 + hstepB, voffB);
            PG8_WAIT_V(6); PG8_BAR; PG8_MMA(1, 1, At, B1); PG8_BAR;
            }
        }
        if constexpr (ALIGN_EPI) { if (wr == 0) PG8_BAR; }
        if constexpr (!Epi::AFTER_DRAIN) { E(acc, cur, wr, wc, fr, fq); S.done(cur); }
        if (!has_next) break;
#pragma unroll
        for (int a = 0; a < 2; ++a)
#pragma unroll
            for (int b = 0; b < 2; ++b)
#pragma unroll
                for (int m = 0; m < 4; ++m)
#pragma unroll
                    for (int n = 0; n < 2; ++n) acc[a][b][m][n] = (f32x4){0.f, 0.f, 0.f, 0.f};
        cur = nxt; cA = nA; cB = nB; ++ui;
        if constexpr (ALIGN_EPI) { if (wr == 1) PG8_BAR; }
    }
    PG8_WAIT_V(0);
    if constexpr (!ALIGN_EPI) { if (wr == 0) PG8_BAR; }
    PG8_BAR;
    if constexpr (Epi::AFTER_DRAIN) { E.fused(acc, cur, wr, wc, fr, fq, lds, wid, lane); S.done(cur); }
#undef PG8_SA
#undef PG8_SB
#undef PG8_STAGE
#undef PG8_LDA
#undef PG8_LDB
#undef PG8_MMA
#undef PG8_WAIT_V
#undef PG8_WAIT_L
#undef PG8_BAR
#undef PG8_SCHED
}
}

namespace att {
typedef unsigned short bf16_t;
typedef short bf16x8 __attribute__((ext_vector_type(8)));
typedef float f32x16 __attribute__((ext_vector_type(16)));
typedef unsigned u32x4 __attribute__((ext_vector_type(4)));
typedef unsigned u32x2 __attribute__((ext_vector_type(2)));
typedef float f32x2_t __attribute__((ext_vector_type(2))); typedef __bf16 bf16x2_t __attribute__((ext_vector_type(2)));
__device__ __forceinline__ unsigned cvtpk(float lo, float hi) { f32x2_t v = {lo, hi}; bf16x2_t b = __builtin_convertvector(v, bf16x2_t); return __builtin_bit_cast(unsigned, b); }
__device__ __forceinline__ float swap_max(float v) { auto rr = __builtin_amdgcn_permlane32_swap(__float_as_uint(v), __float_as_uint(v), false, false); return fmaxf(__uint_as_float(rr[0]), __uint_as_float(rr[1])); }
__device__ __forceinline__ float swap_sum(float v) { auto rr = __builtin_amdgcn_permlane32_swap(__float_as_uint(v), __float_as_uint(v), false, false); return __uint_as_float(rr[0]) + __uint_as_float(rr[1]); }

template <int W>
__device__ __forceinline__ void wave_attn(const bf16_t* Qrow0, int qstride, const char* Kt, const char* Vt, int ntiles, int q0, float m_init, float l_init,
                                          f32x16 (&o)[2], float& m_out, float& l_out, int lane) {
    const int r32 = lane & 31, hi = lane >> 5;
    bf16x8 qf[4];
#pragma unroll
    for (int d0 = 0; d0 < 4; ++d0) qf[d0] = *(const bf16x8*)(Qrow0 + (size_t)r32 * qstride + d0 * 16 + hi * 8);
    const int krow = (r32 & 0x13) | ((r32 & 4) << 1) | ((r32 & 8) >> 1);
    int koff[4], voff[4];
#pragma unroll
    for (int i = 0; i < 4; ++i) { koff[i] = img_off(krow, 2 * i + hi); voff[i] = img_off(r32, 2 * i + hi); }
    o[0] = f32x16{}; o[1] = f32x16{};
    float m = m_init, l = hi == 0 ? l_init : 0.0f;
    int jlo = (q0 - W) >> 6; if (jlo < 0) jlo = 0;
    int jhi = (q0 + 31 + W) >> 6; if (jhi > ntiles - 1) jhi = ntiles - 1;
    for (int j = jlo; j <= jhi; ++j) {
        const char* kt = Kt + (size_t)j * 8192; const char* vt = Vt + (size_t)j * 8192;
        bf16x8 k0[4], k1[4];
#pragma unroll
        for (int d0 = 0; d0 < 4; ++d0) { k0[d0] = *(const bf16x8*)(kt + koff[d0]); k1[d0] = *(const bf16x8*)(kt + koff[d0] + 4096); }
        bf16x8 vf[2][4];
#pragma unroll
        for (int db = 0; db < 2; ++db)
#pragma unroll
            for (int s = 0; s < 4; ++s) vf[db][s] = *(const bf16x8*)(vt + voff[s] + db * 4096);
        f32x16 p0 = f32x16{}, p1 = f32x16{};
#pragma unroll
        for (int d0 = 0; d0 < 4; ++d0) { p0 = __builtin_amdgcn_mfma_f32_32x32x16_bf16(k0[d0], qf[d0], p0, 0, 0, 0); p1 = __builtin_amdgcn_mfma_f32_32x32x16_bf16(k1[d0], qf[d0], p1, 0, 0, 0); }
        const bool full = (64 * j >= q0 + 31 - W) && (64 * j + 63 <= q0 + W);
        if (!full) {
            const int dlt = 64 * j + 8 * hi - (q0 + r32);
#pragma unroll
            for (int r = 0; r < 16; ++r) { const int dk = dlt + 16 * (r >> 3) + (r & 7);
                if (dk < -W || dk > W) p0[r] = -INFINITY;
                if (dk + 32 < -W || dk + 32 > W) p1[r] = -INFINITY; }
        }
        float mx = fmaxf(p0[0], p1[0]);
#pragma unroll
        for (int r = 1; r < 16; ++r) mx = fmaxf(mx, fmaxf(p0[r], p1[r]));
        mx = swap_max(mx);
        const float mn = fmaxf(m, mx);
        const float alpha = __builtin_amdgcn_exp2f(m - mn);
        m = mn; l *= alpha;
#pragma unroll
        for (int r = 0; r < 16; ++r) { o[0][r] *= alpha; o[1][r] *= alpha; }
        float s = 0.f;
#pragma unroll
        for (int r = 0; r < 16; ++r) { p0[r] = __builtin_amdgcn_exp2f(p0[r] - mn); p1[r] = __builtin_amdgcn_exp2f(p1[r] - mn); s += p0[r] + p1[r]; }
        l += s;
        u32x4 w0 = {cvtpk(p0[0], p0[1]), cvtpk(p0[2], p0[3]), cvtpk(p0[4], p0[5]), cvtpk(p0[6], p0[7])};
        u32x4 w1 = {cvtpk(p0[8], p0[9]), cvtpk(p0[10], p0[11]), cvtpk(p0[12], p0[13]), cvtpk(p0[14], p0[15])};
        u32x4 w2 = {cvtpk(p1[0], p1[1]), cvtpk(p1[2], p1[3]), cvtpk(p1[4], p1[5]), cvtpk(p1[6], p1[7])};
        u32x4 w3 = {cvtpk(p1[8], p1[9]), cvtpk(p1[10], p1[11]), cvtpk(p1[12], p1[13]), cvtpk(p1[14], p1[15])};
        const bf16x8 b0 = __builtin_bit_cast(bf16x8, w0), b1 = __builtin_bit_cast(bf16x8, w1), b2 = __builtin_bit_cast(bf16x8, w2), b3 = __builtin_bit_cast(bf16x8, w3);
#pragma unroll
        for (int db = 0; db < 2; ++db) {
            o[db] = __builtin_amdgcn_mfma_f32_32x32x16_bf16(vf[db][0], b0, o[db], 0, 0, 0);
            o[db] = __builtin_amdgcn_mfma_f32_32x32x16_bf16(vf[db][1], b1, o[db], 0, 0, 0);
            o[db] = __builtin_amdgcn_mfma_f32_32x32x16_bf16(vf[db][2], b2, o[db], 0, 0, 0);
            o[db] = __builtin_amdgcn_mfma_f32_32x32x16_bf16(vf[db][3], b3, o[db], 0, 0, 0);
        }
    }
    m_out = m; l_out = swap_sum(l);
}

#define ATT_LAS __attribute__((address_space(3)))
__device__ __forceinline__ void stage_tile(ATT_LAS unsigned char* lds, const char* Kt, const char* Vt, int T, int wave, int lane) {
    if (T >= 0 && T < 128) {
        const unsigned lo = (unsigned)wave * 1024u; const unsigned so = (unsigned)(T & 7) * 16384u;
        const char* kg = Kt + (size_t)T * 8192 + lo + lane * 16; const char* vg = Vt + (size_t)T * 8192 + lo + lane * 16;
        __builtin_amdgcn_global_load_lds((const unsigned*)kg, (ATT_LAS unsigned*)(lds + so + lo), 16, 0, 0);
        __builtin_amdgcn_global_load_lds((const unsigned*)vg, (ATT_LAS unsigned*)(lds + so + 8192 + lo), 16, 0, 0);
    }
}
constexpr float ATT_THR = 8.0f;
template <int W, bool MASKED>
__device__ __forceinline__ void attn_tile(const ATT_LAS unsigned char* tb, const bf16x8 (&qf)[4], const int (&koff)[4], const int (&voff)[4], int dlt,
                                          f32x16 (&o)[2], f32x16& negm, float& mhat, float& l, float& anch) {
    bf16x8 k0[4], k1[4];
#pragma unroll
    for (int d0 = 0; d0 < 4; ++d0) { k0[d0] = *(const ATT_LAS bf16x8*)(tb + koff[d0]); k1[d0] = *(const ATT_LAS bf16x8*)(tb + koff[d0] + 4096); }
    f32x16 p0 = __builtin_amdgcn_mfma_f32_32x32x16_bf16(k0[0], qf[0], negm, 0, 0, 0), p1 = __builtin_amdgcn_mfma_f32_32x32x16_bf16(k1[0], qf[0], negm, 0, 0, 0);
#pragma unroll
    for (int d0 = 1; d0 < 4; ++d0) { p0 = __builtin_amdgcn_mfma_f32_32x32x16_bf16(k0[d0], qf[d0], p0, 0, 0, 0); p1 = __builtin_amdgcn_mfma_f32_32x32x16_bf16(k1[d0], qf[d0], p1, 0, 0, 0); }
    bf16x8 vf0[4];
#pragma unroll
    for (int s = 0; s < 4; ++s) vf0[s] = *(const ATT_LAS bf16x8*)(tb + voff[s]);
    if (MASKED) {
#pragma unroll
        for (int r = 0; r < 16; ++r) { const int dk = dlt + 16 * (r >> 3) + (r & 7);
            if (dk < -W || dk > W) p0[r] = -INFINITY;
            if (dk + 32 < -W || dk + 32 > W) p1[r] = -INFINITY; }
    }
    float ma = fmaxf(fmaxf(p0[0], p0[1]), p1[0]), mb = fmaxf(fmaxf(p0[2], p0[3]), p1[1]);
    ma = fmaxf(fmaxf(ma, p1[2]), p1[3]);
#pragma unroll
    for (int r = 4; r < 16; r += 4) { ma = fmaxf(fmaxf(ma, p0[r]), p0[r + 1]); mb = fmaxf(fmaxf(mb, p0[r + 2]), p0[r + 3]); ma = fmaxf(fmaxf(ma, p1[r]), p1[r + 1]); mb = fmaxf(fmaxf(mb, p1[r + 2]), p1[r + 3]); }
    const float rm = swap_max(fmaxf(ma, mb));
    const bool need = rm > ATT_THR || (anch == 0.0f && rm > -INFINITY);
    if (__builtin_expect(__any(need), 0)) {
        const float dl = need ? rm : 0.0f;
        mhat += dl; anch = need ? 1.0f : anch;
#pragma unroll
        for (int r = 0; r < 16; ++r) { p0[r] -= dl; p1[r] -= dl; }
#pragma unroll
        for (int r = 0; r < 16; ++r) negm[r] = -mhat;
        const float f = __builtin_amdgcn_exp2f(-dl);
        l *= f;
#pragma unroll
        for (int r = 0; r < 16; ++r) { o[0][r] *= f; o[1][r] *= f; }
    }
    float sa = 0.f, sb = 0.f;
#pragma unroll
    for (int r = 0; r < 16; ++r) { p0[r] = __builtin_amdgcn_exp2f(p0[r]); p1[r] = __builtin_amdgcn_exp2f(p1[r]); sa += p0[r]; sb += p1[r]; }
    l += sa + sb;
    u32x4 w0 = {cvtpk(p0[0], p0[1]), cvtpk(p0[2], p0[3]), cvtpk(p0[4], p0[5]), cvtpk(p0[6], p0[7])};
    u32x4 w1 = {cvtpk(p0[8], p0[9]), cvtpk(p0[10], p0[11]), cvtpk(p0[12], p0[13]), cvtpk(p0[14], p0[15])};
    u32x4 w2 = {cvtpk(p1[0], p1[1]), cvtpk(p1[2], p1[3]), cvtpk(p1[4], p1[5]), cvtpk(p1[6], p1[7])};
    u32x4 w3 = {cvtpk(p1[8], p1[9]), cvtpk(p1[10], p1[11]), cvtpk(p1[12], p1[13]), cvtpk(p1[14], p1[15])};
    const bf16x8 b0 = __builtin_bit_cast(bf16x8, w0), b1 = __builtin_bit_cast(bf16x8, w1), b2 = __builtin_bit_cast(bf16x8, w2), b3 = __builtin_bit_cast(bf16x8, w3);
    bf16x8 vf1[4];
#pragma unroll
    for (int s = 0; s < 4; ++s) vf1[s] = *(const ATT_LAS bf16x8*)(tb + voff[s] + 4096);
    o[0] = __builtin_amdgcn_mfma_f32_32x32x16_bf16(vf0[0], b0, o[0], 0, 0, 0);
    o[0] = __builtin_amdgcn_mfma_f32_32x32x16_bf16(vf0[1], b1, o[0], 0, 0, 0);
    o[0] = __builtin_amdgcn_mfma_f32_32x32x16_bf16(vf0[2], b2, o[0], 0, 0, 0);
    o[0] = __builtin_amdgcn_mfma_f32_32x32x16_bf16(vf0[3], b3, o[0], 0, 0, 0);
    o[1] = __builtin_amdgcn_mfma_f32_32x32x16_bf16(vf1[0], b0, o[1], 0, 0, 0);
    o[1] = __builtin_amdgcn_mfma_f32_32x32x16_bf16(vf1[1], b1, o[1], 0, 0, 0);
    o[1] = __builtin_amdgcn_mfma_f32_32x32x16_bf16(vf1[2], b2, o[1], 0, 0, 0);
    o[1] = __builtin_amdgcn_mfma_f32_32x32x16_bf16(vf1[3], b3, o[1], 0, 0, 0);
}
template <int W, bool HAS_SINK>
__device__ __forceinline__ void wave_attn_lds(const bf16x8 (&qf)[4], const ATT_LAS unsigned char* lds, int tsh, int ntiles, int q0, float sink2,
                                              f32x16 (&o)[2], float& m_out, float& l_out, int lane) {
    const int r32 = lane & 31, hi = lane >> 5;
    const int krow = (r32 & 0x13) | ((r32 & 4) << 1) | ((r32 & 8) >> 1);
    int koff[4], voff[4];
#pragma unroll
    for (int i = 0; i < 4; ++i) { koff[i] = img_off(krow, 2 * i + hi); voff[i] = 8192 + img_off(r32, 2 * i + hi); }
    o[0] = f32x16{}; o[1] = f32x16{};
    float mhat = HAS_SINK ? sink2 : 0.0f, l = (HAS_SINK && hi == 0) ? 1.0f : 0.0f, anch = HAS_SINK ? 1.0f : 0.0f;
    f32x16 negm;
#pragma unroll
    for (int r = 0; r < 16; ++r) negm[r] = -mhat;
    int jlo = (q0 - W) >> 6; if (jlo < 0) jlo = 0;
    int jhi = (q0 + 31 + W) >> 6; if (jhi > ntiles - 1) jhi = ntiles - 1;
    for (int j = jlo; j <= jhi; ++j) {
        const ATT_LAS unsigned char* tb = lds + ((j + tsh) & 7) * 16384;
        const bool full = (64 * j >= q0 + 31 - W) && (64 * j + 63 <= q0 + W);
        if (full) attn_tile<W, false>(tb, qf, koff, voff, 0, o, negm, mhat, l, anch);
        else attn_tile<W, true>(tb, qf, koff, voff, 64 * j + 8 * hi - (q0 + r32), o, negm, mhat, l, anch);
    }
    m_out = mhat; l_out = swap_sum(l);
}
__device__ __forceinline__ void load_q_asm(bf16x8 (&qf)[4], const bf16_t* Qrow0, int qstride, int lane) {
    const int r32 = lane & 31, hi = lane >> 5; const bf16_t* p = Qrow0 + (size_t)r32 * qstride + hi * 8;
    asm volatile("global_load_dwordx4 %0, %1, off" : "=v"(qf[0]) : "v"(p) : "memory");
    asm volatile("global_load_dwordx4 %0, %1, off offset:32" : "=v"(qf[1]) : "v"(p) : "memory");
    asm volatile("global_load_dwordx4 %0, %1, off offset:64" : "=v"(qf[2]) : "v"(p) : "memory");
    asm volatile("global_load_dwordx4 %0, %1, off offset:96" : "=v"(qf[3]) : "v"(p) : "memory");
}
__device__ __forceinline__ void load_q(bf16x8 (&qf)[4], const bf16_t* Qrow0, int qstride, int lane) {
    const int r32 = lane & 31, hi = lane >> 5;
#pragma unroll
    for (int d0 = 0; d0 < 4; ++d0) qf[d0] = *(const bf16x8*)(Qrow0 + (size_t)r32 * qstride + d0 * 16 + hi * 8);
}
__device__ __forceinline__ void store_o(bf16_t* orow, const f32x16 (&o)[2], float inv, int hi) {
#pragma unroll
    for (int db = 0; db < 2; ++db)
#pragma unroll
        for (int k4 = 0; k4 < 4; ++k4) { u32x2 w; w.x = cvtpk(o[db][4 * k4] * inv, o[db][4 * k4 + 1] * inv); w.y = cvtpk(o[db][4 * k4 + 2] * inv, o[db][4 * k4 + 3] * inv);
            *(u32x2*)(orow + db * 32 + k4 * 8 + hi * 4) = w; }
}
template <class RowFn>
__device__ __forceinline__ void store_o_staged(ATT_LAS unsigned char* stg, const f32x16 (&o)[2], float inv, int lane, const RowFn& rowp) {
    const int r32 = lane & 31, hi = lane >> 5;
#pragma unroll
    for (int db = 0; db < 2; ++db) {
#pragma unroll
        for (int k4 = 0; k4 < 4; ++k4) { u32x2 w; w.x = cvtpk(o[db][4 * k4] * inv, o[db][4 * k4 + 1] * inv); w.y = cvtpk(o[db][4 * k4 + 2] * inv, o[db][4 * k4 + 3] * inv);
            *(ATT_LAS u32x2*)(stg + r32 * 64 + ((k4 ^ ((r32 >> 1) & 3)) << 4) + hi * 8) = w; }
#pragma unroll
        for (int t = 0; t < 2; ++t) { const int c = lane + 64 * t, rr = c >> 2, cc = c & 3;
            const u32x4 v = *(const ATT_LAS u32x4*)(stg + rr * 64 + ((cc ^ ((rr >> 1) & 3)) << 4));
            *(u32x4*)(rowp(rr) + db * 32 + cc * 8) = v; }
    }
}
}

constexpr int NWAVES = 8;
constexpr int N_LAUNCHES = MK_N_LAUNCHES;
constexpr int PER_PHASE = 10;
#ifndef MK_CUTS
#define MK_CUTS {0, 10}
#endif
constexpr int CUTS[] = MK_CUTS;
constexpr int N_CUT_LAUNCHES = (int)(sizeof(CUTS) / sizeof(int)) - 1;

constexpr size_t MiB = 1u << 20;
constexpr size_t WS_CTL = 0, CTL_ZERO_BYTES = 1 * MiB;
constexpr size_t WS_ROPE = 1 * MiB;
constexpr size_t WS_W1 = 2 * MiB;
constexpr size_t WS_WV = 12 * MiB;
constexpr size_t WS_WA = 14 * MiB, WS_WB = 16 * MiB, WS_WO = 17 * MiB;
constexpr size_t WS_WGU = 19 * MiB;
constexpr size_t WS_WD = 30 * MiB;
constexpr size_t WS_ST = 36 * MiB;
constexpr size_t WS_XB = 64 * MiB;
constexpr size_t WS_QA = 192 * MiB;
constexpr size_t WS_KA = 320 * MiB, WS_VAT = 352 * MiB;
constexpr size_t WS_QB = 384 * MiB, WS_KB = 480 * MiB, WS_VBT = 576 * MiB;
constexpr size_t WS_GT = 672 * MiB;
constexpr size_t WS_OBG = 928 * MiB;
constexpr size_t WS_T = 192 * MiB;
constexpr size_t WS_END = 1024 * MiB;
static_assert(WS_T + (size_t)MTOK * DFF * 2 <= WS_GT && WS_OBG + (size_t)3 * MTOK * 256 * 2 <= WS_END && WS_WD + (size_t)1024 * DFF * 2 <= WS_ST, "d_ws map");
constexpr int CW_TMO = 0, CW_CODE = 1, CW_BAR = 4096;

constexpr int RING_OFF = 0, RING_BYTES = 131072;
constexpr int OSTG_OFF = RING_BYTES, OSTG_BYTES = 16384;
constexpr int LDSCTL_OFF = OSTG_OFF + OSTG_BYTES, MISC_OFF = LDSCTL_OFF + 320;
constexpr int LDS_BYTES = LDSCTL_OFF + 512;

#define GAS __attribute__((address_space(1)))
#define LAS __attribute__((address_space(3)))
typedef unsigned short bf16;
typedef unsigned v4u __attribute__((ext_vector_type(4)));
typedef float f32x4 __attribute__((ext_vector_type(4)));
typedef short bf16x8 __attribute__((ext_vector_type(8)));
typedef GAS unsigned gu32;
typedef GAS unsigned long long gu64;
#define RLX_AGENT __ATOMIC_RELAXED, __HIP_MEMORY_SCOPE_AGENT
#define LDS_WAIT() asm volatile("s_waitcnt lgkmcnt(0)" ::: "memory")
#define VM_WAIT() asm volatile("s_waitcnt vmcnt(0)" ::: "memory")
__device__ __forceinline__ unsigned long long rt() { return __builtin_amdgcn_s_memrealtime(); }
__device__ __forceinline__ unsigned f2bf(float f) { unsigned u = __builtin_bit_cast(unsigned, f); return (u + 0x7fffu + ((u >> 16) & 1u)) >> 16; }
__device__ __forceinline__ unsigned pk2(float lo, float hi) { return f2bf(lo) | (f2bf(hi) << 16); }

#define XB_TMO      128
#define XB_XCNT(j)  (256  + 64 * (j))
#define XB_XSUB(j)  (1280 + 64 * (j))
#define XB_XGEN(j)  (2304 + 64 * (j))
#define XB_TOP      3328
#define XB_TOPGEN   3392
#define XCD_BAR_WORDS 3456
#define XB_SPIN_CAP (1u << 18)

__device__ __forceinline__ unsigned xb_ld(unsigned* p)              { return __hip_atomic_load(p, __ATOMIC_RELAXED, __HIP_MEMORY_SCOPE_AGENT); }
__device__ __forceinline__ unsigned xb_add(unsigned* p, unsigned v) { return __hip_atomic_fetch_add(p, v, __ATOMIC_RELAXED, __HIP_MEMORY_SCOPE_AGENT); }
__device__ __forceinline__ unsigned xb_xcc_id() { return (unsigned)__builtin_amdgcn_s_getreg((3 << 11) | 20) & 0xFu; }
#define XB_SPIN(cond, bar) do { unsigned _sp = 0; while (cond) { __builtin_amdgcn_s_sleep(1); \
    if ((++_sp & 255u) == 0u) { if (xb_ld(&(bar)[XB_TMO])) break; if (_sp > XB_SPIN_CAP) { atomicAdd(&(bar)[XB_TMO], 1u); break; } } } } while (0)

struct XcdBarrier {
    unsigned* bar; unsigned x;
    volatile LAS unsigned* st;
};

__device__ __forceinline__ XcdBarrier xcd_barrier_post(unsigned* bar, volatile LAS unsigned* st) {
    XcdBarrier b; b.bar = bar; b.x = xb_xcc_id(); b.st = st;
    if (threadIdx.x == 0) (void)xb_add(&bar[XB_XCNT(b.x)], 1u);
    return b;
}
__device__ __forceinline__ void xcd_barrier_complete(unsigned* bar, unsigned x, unsigned& nloc, unsigned& nx) {
    const unsigned G = gridDim.x * gridDim.y * gridDim.z;
    unsigned sum, cnt, mine, sp = 0u;
    for (;;) {
        sum = 0u; cnt = 0u; mine = 0u;
#pragma unroll
        for (unsigned j = 0; j < 16; ++j) { const unsigned c = xb_ld(&bar[XB_XCNT(j)]); sum += c; cnt += (c > 0u) ? 1u : 0u; mine = (j == x) ? c : mine; }
        if (sum == G) break;
        __builtin_amdgcn_s_sleep(1);
        if ((++sp & 255u) == 0u) { if (xb_ld(&bar[XB_TMO])) break; if (sp > XB_SPIN_CAP) { atomicAdd(&bar[XB_TMO], 1u); break; } }
    }
    nloc = mine > 0u ? mine : 1u; nx = cnt > 0u ? cnt : 1u;
}

__device__ __forceinline__ void xcd_barrier(const XcdBarrier& b) {
    asm volatile("s_waitcnt vmcnt(0)" ::: "memory");
    __syncthreads();
    if (threadIdx.x == 0) {
        unsigned* bar = b.bar;
        __builtin_amdgcn_s_waitcnt(0);
        unsigned nloc = b.st[0], nx = b.st[1];
        if (nloc == 0u) { xcd_barrier_complete(bar, b.x, nloc, nx); b.st[0] = nloc; b.st[1] = nx; }
        const unsigned old = xb_add(&bar[XB_XSUB(b.x)], 1u);
        const unsigned gen = old / nloc;
        if (old + 1u == (gen + 1u) * nloc) {
            __builtin_amdgcn_fence(__ATOMIC_RELEASE, "agent");
            asm volatile("s_waitcnt vmcnt(0)" ::: "memory");
            const unsigned og = xb_add(&bar[XB_TOP], 1u);
            const unsigned tg = og / nx;
            if (og + 1u == (tg + 1u) * nx) xb_add(&bar[XB_TOPGEN], 1u);
            else XB_SPIN(xb_ld(&bar[XB_TOPGEN]) == tg, bar);
            __builtin_amdgcn_fence(__ATOMIC_ACQUIRE, "agent");
            xb_add(&bar[XB_XGEN(b.x)], 1u);
            asm volatile("s_waitcnt vmcnt(0)" ::: "memory");
        } else {
            XB_SPIN(xb_ld(&bar[XB_XGEN(b.x)]) == gen, bar);
            __builtin_amdgcn_fence(__ATOMIC_ACQUIRE, "agent");
            asm volatile("s_waitcnt vmcnt(0)" ::: "memory");
        }
    }
    __syncthreads();
}

__device__ __forceinline__ void xcc_local_barrier(const XcdBarrier& b) {
    asm volatile("s_waitcnt vmcnt(0)" ::: "memory");
    __syncthreads();
    if (threadIdx.x == 0) {
        unsigned* bar = b.bar;
        __builtin_amdgcn_s_waitcnt(0);
        unsigned nloc = b.st[0], nx = b.st[1];
        if (nloc == 0u) { xcd_barrier_complete(bar, b.x, nloc, nx); b.st[0] = nloc; b.st[1] = nx; }
        const unsigned old = xb_add(&bar[XB_XSUB(b.x)], 1u);
        const unsigned gen = old / nloc;
        if (old + 1u == (gen + 1u) * nloc) xb_add(&bar[XB_XGEN(b.x)], 1u);
        else XB_SPIN(xb_ld(&bar[XB_XGEN(b.x)]) == gen, bar);
        __builtin_amdgcn_fence(__ATOMIC_ACQUIRE, "agent");
        asm volatile("s_waitcnt vmcnt(0)" ::: "memory");
    }
    __syncthreads();
}

struct Frame {
    LAS unsigned char* lds;
    volatile LAS unsigned* MISC;
    gu32* ctl;
    int tid, lane, wave;
    int vcu, G, xcc, rank;
    unsigned char* ws;
};

__device__ __forceinline__ float wave_sum(float v) {
#pragma unroll
    for (int o = 1; o < 64; o <<= 1) v += __shfl_xor(v, o);
    return v;
}
__device__ __forceinline__ void p0_transpose_item(const float* W, int ldw, int K, int c0, int k0, bf16* WT, int drow, LAS float* scr, int lane) {
#pragma unroll 8
    for (int i = 0; i < 32; ++i) { const int kk = 2 * i + (lane >> 5); scr[kk * 33 + (lane & 31)] = W[(size_t)(k0 + kk) * ldw + c0 + (lane & 31)]; }
    LDS_WAIT(); asm volatile("" ::: "memory");
    const int c = lane & 7;
#pragma unroll
    for (int j = 0; j < 4; ++j) { const int n = (lane >> 3) + 8 * j; const LAS float* s = scr + (8 * c) * 33 + n;
        v4u o; o.x = pk2(s[0 * 33], s[1 * 33]); o.y = pk2(s[2 * 33], s[3 * 33]); o.z = pk2(s[4 * 33], s[5 * 33]); o.w = pk2(s[6 * 33], s[7 * 33]);
        *(GAS v4u*)(WT + (size_t)(drow + n) * K + k0 + 8 * c) = o; }
    LDS_WAIT(); asm volatile("" ::: "memory");
}
#define P0_MATRIX(W, ldw, K, N, WTexpr, DROWexpr) if (!done_) { const int nblk = (N) / 32, nit = ((K) / 64) * nblk; \
    if (r < nit) { const int kb = r / nblk, n0 = (r % nblk) * 32; p0_transpose_item((W), (ldw), (K), n0, kb * 64, (WTexpr), (DROWexpr), scr, F.lane); done_ = true; } else r -= nit; }

struct Args { const float* in[15]; float* out; unsigned char* ws; int ph_lo, ph_hi, li, pad; };

__device__ __forceinline__ void p0_prologue(Frame& F, const Args& a) {
    LAS float* scr = (LAS float*)(F.lds + RING_OFF + F.wave * 16384);
    const int gw = F.vcu * NWAVES + F.wave, NGW = F.G * NWAVES;
    bf16* W1 = (bf16*)(F.ws + WS_W1); bf16* WV = (bf16*)(F.ws + WS_WV); bf16* WA = (bf16*)(F.ws + WS_WA); bf16* WB = (bf16*)(F.ws + WS_WB);
    bf16* WO = (bf16*)(F.ws + WS_WO); bf16* WGU = (bf16*)(F.ws + WS_WGU); bf16* WD = (bf16*)(F.ws + WS_WD);
    const float *w_in = a.in[1], *w_gate = a.in[3], *w_br_a = a.in[5], *w_br_b = a.in[6], *w_out = a.in[7], *w_ffg = a.in[10], *w_ffu = a.in[11], *w_ffd = a.in[12];
    constexpr int NITEMS = 16 * 120 + 16 * 64 + 16 * 32 + 4 * 32 + 16 * 32 + 16 * 88 * 2 + 44 * 32;
    for (int it = gw; it < NITEMS; it += NGW) {
        int r = it; bool done_ = false;
        P0_MATRIX(w_in, IN_W, 1024, IN_W, ((n0 >= 1280 && n0 < 1536) || n0 >= 3072) ? WV : W1, n0 < 1280 ? n0 : (n0 < 1536 ? n0 - 1280 : (n0 < 3072 ? n0 - 256 : n0 - 3072 + 256)));
        P0_MATRIX(w_gate, 2048, 1024, 2048, W1, 2816 + n0);
        P0_MATRIX(w_br_a, 1024, 1024, 1024, WA, n0);
        P0_MATRIX(w_br_b, 1024, 256, 1024, WB, n0);
        P0_MATRIX(w_out, 1024, 1024, 1024, WO, n0);
        P0_MATRIX(w_ffg, DFF, 1024, DFF, WGU, 256 * (n0 >> 7) + (n0 & 127));
        P0_MATRIX(w_ffu, DFF, 1024, DFF, WGU, 256 * (n0 >> 7) + 128 + (n0 & 127));
        P0_MATRIX(w_ffd, 1024, DFF, 1024, WD, n0);
    }
    const float* x = a.in[0]; bf16* XB = (bf16*)(F.ws + WS_XB);
    for (int j = F.rank * NWAVES + F.wave; j < SEQ; j += 32 * NWAVES) { const int m = F.xcc * SEQ + j;
        const GAS f32x4* xr = (const GAS f32x4*)(x + (size_t)m * DM) + F.lane;
        GAS unsigned long long* o8 = (GAS unsigned long long*)(XB + (size_t)m * DM) + F.lane;
        f32x4 v[4];
#pragma unroll
        for (int j = 0; j < 4; ++j) v[j] = xr[64 * j];
#pragma unroll
        for (int j = 0; j < 4; ++j) o8[64 * j] = (unsigned long long)pk2(v[j].x, v[j].y) | ((unsigned long long)pk2(v[j].z, v[j].w) << 32);
    }
    float* rope = (float*)(F.ws + WS_ROPE);
    for (int e = F.vcu * 512 + F.tid; e < 8192 * 8; e += F.G * 512) {
        const int pos = e >> 3, i = e & 7;
        const float inv = i == 0 ? 1.0f : i == 1 ? 0.1939227432012558f : i == 2 ? 0.03760603070259094f : i == 3 ? 0.007292664609849453f : i == 4 ? 0.0014142135623842478f
                        : i == 5 ? 0.00027424818836152554f : i == 6 ? 5.318296098266728e-05f : 1.0313386155758053e-05f;
        const float ang = (float)pos * inv;
        const double rev = (double)ang * 0.15915494309189535; const float fr = (float)(rev - __builtin_rint(rev));
        rope[pos * 16 + i] = __builtin_amdgcn_cosf(fr); rope[pos * 16 + 8 + i] = __builtin_amdgcn_sinf(fr);
    }
}

__device__ __forceinline__ void ln_rows(Frame& F, const float* in, const float* gam, const float* bet, float* outf, bf16* outb) {
    f32x4 gv[4], bv[4];
#pragma unroll
    for (int j = 0; j < 4; ++j) { gv[j] = ((const GAS f32x4*)gam)[F.lane + 64 * j]; bv[j] = ((const GAS f32x4*)bet)[F.lane + 64 * j]; }
    for (int j = F.rank * NWAVES + F.wave; j < SEQ; j += 32 * NWAVES) { const int m = F.xcc * SEQ + j;
        const GAS f32x4* xr = (const GAS f32x4*)(in + (size_t)m * DM) + F.lane;
        f32x4 v[4]; float s = 0.f;
#pragma unroll
        for (int j = 0; j < 4; ++j) { v[j] = xr[64 * j]; s += (v[j].x + v[j].y) + (v[j].z + v[j].w); }
        const float mean = wave_sum(s) * (1.f / DM); float s2 = 0.f;
#pragma unroll
        for (int j = 0; j < 4; ++j) { v[j] = v[j] - mean; s2 += (v[j].x * v[j].x + v[j].y * v[j].y) + (v[j].z * v[j].z + v[j].w * v[j].w); }
        const float rstd = 1.f / sqrtf(wave_sum(s2) * (1.f / DM) + LN_EPS);
        GAS f32x4* of = (GAS f32x4*)(outf + (size_t)m * DM) + F.lane;
#pragma unroll
        for (int j = 0; j < 4; ++j) { v[j] = v[j] * rstd * gv[j] + bv[j]; of[64 * j] = v[j]; }
        if (outb) { GAS unsigned long long* o8 = (GAS unsigned long long*)(outb + (size_t)m * DM) + F.lane;
#pragma unroll
            for (int j = 0; j < 4; ++j) o8[64 * j] = (unsigned long long)pk2(v[j].x, v[j].y) | ((unsigned long long)pk2(v[j].z, v[j].w) << 32); }
    }
}

__global__ void __launch_bounds__(NWAVES * 64, 2) skel_fwd(Args args) {
    extern __shared__ __attribute__((aligned(16))) unsigned char lds[];
    Frame F;
    F.lds = (LAS unsigned char*)lds;
    F.MISC = (volatile LAS unsigned*)(F.lds + MISC_OFF);
    F.tid = threadIdx.x; F.lane = F.tid & 63; F.wave = __builtin_amdgcn_readfirstlane(F.tid >> 6);
    F.G = gridDim.x;
    F.ws = args.ws; F.ctl = (gu32*)(args.ws + WS_CTL);
    unsigned char* ws = args.ws;
    for (int u = F.tid; u < (LDS_BYTES - LDSCTL_OFF) / 4; u += NWAVES * 64) ((LAS unsigned*)(F.lds + LDSCTL_OFF))[u] = 0u;
    __syncthreads();
    unsigned* barw = (unsigned*)(F.ctl + CW_BAR) + args.li * XCD_BAR_WORDS;
    if (F.tid == 0) { const unsigned x = xb_xcc_id(); const unsigned r = xb_add(&barw[XB_XCNT(x)], 1u); F.MISC[10] = x; F.MISC[11] = r;
        if (x >= 8u || r >= 32u) __hip_atomic_store(F.ctl + CW_TMO, 0xBAD0u, RLX_AGENT); }
    __syncthreads();
    F.xcc = (int)(F.MISC[10] & 7u); F.rank = (int)(F.MISC[11] & 31u); F.vcu = F.xcc * 32 + F.rank;
    XcdBarrier bar; bar.bar = barw; bar.x = (unsigned)F.xcc; bar.st = F.MISC + 8;
#define GRID_BAR() do { xcd_barrier(bar); } while (0)
#define XCC_BAR() do { xcc_local_barrier(bar); } while (0)
#define REFRESH() do { int t_ = threadIdx.x; asm volatile("" : "+v"(t_)); F.tid = t_; F.lane = t_ & 63; F.wave = __builtin_amdgcn_readfirstlane(t_ >> 6); } while (0)
    const int ph_lo_ = args.ph_lo, ph_hi_ = args.ph_hi;
#define IN(k) (ph_lo_ <= (k) && (k) < ph_hi_)
#define BOTH(k) (IN(k) && IN((k) + 1))
    typedef pg8::bf16_t b16;
    b16* XB = (b16*)(ws + WS_XB); b16* QA = (b16*)(ws + WS_QA); b16* KA = (b16*)(ws + WS_KA); b16* VAT = (b16*)(ws + WS_VAT);
    b16* QB = (b16*)(ws + WS_QB); b16* KB = (b16*)(ws + WS_KB); b16* VBT = (b16*)(ws + WS_VBT); b16* GT = (b16*)(ws + WS_GT);
    b16* OA = XB; b16* OBG = (b16*)(ws + WS_OBG); b16* OB = KA; b16* MX = QA; b16* H1B = XB; b16* TT = (b16*)(ws + WS_T);
    float* ST = (float*)(ws + WS_ST);
    const b16* W1 = (const b16*)(ws + WS_W1); const b16* WV = (const b16*)(ws + WS_WV); const b16* WA = (const b16*)(ws + WS_WA); const b16* WB = (const b16*)(ws + WS_WB);
    const b16* WO = (const b16*)(ws + WS_WO); const b16* WGU = (const b16*)(ws + WS_WGU); const b16* WD = (const b16*)(ws + WS_WD);
    const int G = F.G, bx = F.rank * 8 + F.xcc;

    if (IN(0)) { REFRESH(); p0_prologue(F, args); if (BOTH(0)) GRID_BAR(); }

    if (IN(1)) { REFRESH();
        { pg8::Gemm g{XB, W1, MTOK, 4864, 1024, 1}; pg8::StaticOrder S; S.init(MTOK, 4864, G, bx);
          pg8::EpiProj E{QA, KA, QB, KB, GT, (const float*)(ws + WS_ROPE), args.in[4]};
          pg8::gemm_phase<pg8::EpiProj, pg8::StaticOrder, true, true>(F.lds + RING_OFF, g, S, E); }
        { pg8::Gemm g{WV, XB, 512, MTOK, 1024, 1}; pg8::StaticOrder S; S.init(512, MTOK, G, bx);
          pg8::EpiVT E{{VAT, VBT}, {4, 12}, {0, 0}};
          pg8::gemm_phase<pg8::EpiVT, pg8::StaticOrder, true, true>(F.lds + RING_OFF, g, S, E); }
        { pg8::Gemm g{WV + (size_t)512 * 1024, XB, 256, MTOK, 1024, 4}; pg8::StaticOrder S; S.init(256, MTOK, G, bx);
          pg8::EpiVT E{{VBT, VBT}, {12, 12}, {4, 4}};
          pg8::gemm_phase<pg8::EpiVT, pg8::StaticOrder, true, true>(F.lds + RING_OFF, g, S, E); }
        { pg8::Gemm g{WV + (size_t)768 * 1024, XB, 256, MTOK, 1024, 16}; pg8::StaticOrder S; S.init(256, MTOK, G, bx);
          pg8::EpiVT E{{VBT, VBT}, {12, 12}, {8, 8}};
          pg8::gemm_phase<pg8::EpiVT, pg8::StaticOrder, true, true>(F.lds + RING_OFF, g, S, E); }
        if (BOTH(1)) XCC_BAR();
    }

    if (IN(2)) { REFRESH();
        const int lane = F.lane, w = F.wave, r32 = lane & 31, hi = lane >> 5;
        const float* sink = args.in[2];
        ATT_LAS unsigned char* albs = (ATT_LAS unsigned char*)(F.lds + RING_OFF);
        ATT_LAS unsigned char* ostg = (ATT_LAS unsigned char*)(F.lds + OSTG_OFF + w * 2048);
        {
            const int strip = F.vcu >> 3, i0 = (F.vcu & 7) * 16, b = strip >> 2, kvh = strip & 3, h = kvh * 4 + (w >> 1);
            const char* Ks = (const char*)(KA + (size_t)strip * 128 * 4096); const char* Vs = (const char*)(VAT + (size_t)strip * 128 * 4096);
            const float sk = sink[h] * LOG2E;
            for (int T = i0 - 2; T <= i0 + 2; ++T) att::stage_tile(albs, Ks, Vs, T, w, lane);
            att::bf16x8 qf[4]; att::load_q(qf, QA + (size_t)(b * 8192 + i0 * 64 + 32 * (w & 1)) * 1024 + h * 64, 1024, lane);
            __syncthreads();
            for (int k = 0; k < 16; ++k) {
                const int blk = i0 + k, q0 = blk * 64 + 32 * (w & 1);
                if (k < 15) att::stage_tile(albs, Ks, Vs, blk + 3, w, lane);
                att::bf16x8 qn[4];
                att::load_q_asm(qn, QA + (size_t)(b * 8192 + (k < 15 ? q0 + 64 : q0)) * 1024 + h * 64, 1024, lane);
                att::f32x16 o[2]; float m, l;
                att::wave_attn_lds<128, true>(qf, albs, 0, 128, q0, sk, o, m, l, lane);
                att::store_o_staged(ostg, o, 1.0f / l, lane, [&](int i) { return OA + (size_t)(b * 8192 + q0 + i) * 1024 + h * 64; });
                asm volatile("s_waitcnt vmcnt(4) lgkmcnt(0)" : "+v"(qn[0]), "+v"(qn[1]), "+v"(qn[2]), "+v"(qn[3]) :: "memory");
                __builtin_amdgcn_s_barrier(); asm volatile("" ::: "memory");
#pragma unroll
                for (int d0 = 0; d0 < 4; ++d0) qf[d0] = qn[d0];
            }
        }
        {
            bool need_full = true; att::bf16x8 qf[4];
            for (int k = 0; k < 12; ++k) {
                const int U = F.vcu * 12 + k, blk = U & 31, strip = U >> 5, hs = strip & 3, bg = strip >> 2, g = bg % 3, b = bg / 3, Tb = blk * 4;
                const char* Ks = (const char*)(KB + (size_t)strip * 128 * 4096); const char* Vs = (const char*)(VBT + (size_t)strip * 128 * 4096);
                const int p0 = blk * 256 + 32 * w;
                const int L = g == 0 ? 8192 : (g == 1 ? 2048 : 512), seq = p0 / L, q0 = p0 % L;
                if (need_full) { for (int T = Tb - 1; T <= Tb + 4; ++T) att::stage_tile(albs, Ks, Vs, T, w, lane);
                    att::load_q(qf, QB + (size_t)(b * 8192 + p0) * 768 + g * 256 + hs * 64, 768, lane); __syncthreads(); }
                const bool cont = (k + 1 < 12) && (blk + 1 < 32);
                if (cont) { att::stage_tile(albs, Ks, Vs, Tb + 5, w, lane); att::stage_tile(albs, Ks, Vs, Tb + 6, w, lane); }
                att::f32x16 o[2]; float m, l;
                att::wave_attn_lds<64, false>(qf, albs, seq * (L >> 6), L >> 6, q0, 0.0f, o, m, l, lane);
                const int pq = q0 + r32, t = g == 0 ? pq : (g == 1 ? pq * 4 + seq : pq * 16 + seq);
                const size_t tok = (size_t)b * 8192 + t;
                att::store_o_staged(ostg, o, 1.0f / l, lane, [&](int i) { const int pi = q0 + i, ti = g == 0 ? pi : (g == 1 ? pi * 4 + seq : pi * 16 + seq);
                    return OBG + ((size_t)g * MTOK + (size_t)b * 8192 + ti) * 256 + hs * 64; });
                if (hi == 0) { typedef float f32x2v __attribute__((ext_vector_type(2))); *(f32x2v*)(ST + (((size_t)g * MTOK + tok) * 4 + hs) * 2) = (f32x2v){m, l}; }
                if (cont) att::load_q(qf, QB + (size_t)(b * 8192 + p0 + 256) * 768 + g * 256 + hs * 64, 768, lane);
                __syncthreads();
                if (cont) { att::stage_tile(albs, Ks, Vs, Tb + 7, w, lane); att::stage_tile(albs, Ks, Vs, Tb + 8, w, lane); __syncthreads(); }
                need_full = !cont;
            }
        }
        if (BOTH(2)) XCC_BAR();
    }

    if (IN(3)) { REFRESH();
        for (int il = F.rank * 512 + F.tid; il < SEQ * 32; il += 32 * 512) {
            const size_t tok = (size_t)F.xcc * SEQ + (il >> 5); const int hs = (il >> 3) & 3, dc = il & 7;
            float mg[3], lg[3];
#pragma unroll
            for (int g = 0; g < 3; ++g) { const unsigned long long w_ = __hip_atomic_load((const gu64*)(ST + (((size_t)g * MTOK + tok) * 4 + hs) * 2), RLX_AGENT); mg[g] = __uint_as_float((unsigned)w_); lg[g] = __uint_as_float((unsigned)(w_ >> 32)); }
            const float M = fmaxf(mg[0], fmaxf(mg[1], mg[2]));
            float wg[3], ws_ = 0.f;
#pragma unroll
            for (int g = 0; g < 3; ++g) { wg[g] = lg[g] * __builtin_amdgcn_exp2f(mg[g] - M); ws_ += wg[g]; }
            const float inv = 1.0f / ws_;
            float acc[8] = {0.f, 0.f, 0.f, 0.f, 0.f, 0.f, 0.f, 0.f};
#pragma unroll
            for (int g = 0; g < 3; ++g) { const gu64* op_ = (const gu64*)(OBG + ((size_t)g * MTOK + tok) * 256 + hs * 64 + dc * 8); const unsigned long long a_ = __hip_atomic_load(op_, RLX_AGENT), b_ = __hip_atomic_load(op_ + 1, RLX_AGENT);
                v4u v; v.x = (unsigned)a_; v.y = (unsigned)(a_ >> 32); v.z = (unsigned)b_; v.w = (unsigned)(b_ >> 32); const float wq = wg[g] * inv;
                acc[0] += wq * pg8::bf_lo(v.x); acc[1] += wq * pg8::bf_hi(v.x); acc[2] += wq * pg8::bf_lo(v.y); acc[3] += wq * pg8::bf_hi(v.y);
                acc[4] += wq * pg8::bf_lo(v.z); acc[5] += wq * pg8::bf_hi(v.z); acc[6] += wq * pg8::bf_lo(v.w); acc[7] += wq * pg8::bf_hi(v.w); }
            v4u o; o.x = pk2(acc[0], acc[1]); o.y = pk2(acc[2], acc[3]); o.z = pk2(acc[4], acc[5]); o.w = pk2(acc[6], acc[7]);
            *(v4u*)(OB + tok * 256 + hs * 64 + dc * 8) = o;
        }
        if (BOTH(3)) XCC_BAR();
    }

    if (IN(4)) { REFRESH();
        { pg8::Gemm g{OB, WB, MTOK, 1024, 256, 1}; pg8::StaticOrder S; S.init(MTOK, 1024, G, bx);
          pg8::EpiGate<true> E{MX, GT, 1024};
          pg8::gemm_phase<pg8::EpiGate<true>, pg8::StaticOrder, true, true>(F.lds + RING_OFF, g, S, E); }
        { pg8::Gemm g{OA, WA, MTOK, 1024, 1024, 1}; pg8::StaticOrder S; S.init(MTOK, 1024, G, bx);
          pg8::EpiGate<false> E{MX, GT, 0};
          pg8::gemm_phase<pg8::EpiGate<false>, pg8::StaticOrder, true, true>(F.lds + RING_OFF, g, S, E); }
        if (BOTH(4)) XCC_BAR();
    }

    if (IN(5)) { REFRESH();
        pg8::Gemm g{MX, WO, MTOK, 1024, 1024, 1}; pg8::StaticOrder S; S.init(MTOK, 1024, G, bx);
        pg8::EpiRes E{args.in[0], args.out, 1};
        pg8::gemm_phase<pg8::EpiRes, pg8::StaticOrder, true, true>(F.lds + RING_OFF, g, S, E);
        if (BOTH(5)) XCC_BAR();
    }
    if (IN(6)) { REFRESH(); ln_rows(F, args.out, args.in[8], args.in[9], args.out, (bf16*)H1B); if (BOTH(6)) XCC_BAR(); }

    if (IN(7)) { REFRESH();
        pg8::Gemm g{H1B, WGU, MTOK, 5632, 1024, 1}; pg8::StaticOrder S; S.init(MTOK, 5632, G, bx);
        pg8::EpiSwiGLU E{TT};
        pg8::gemm_phase<pg8::EpiSwiGLU, pg8::StaticOrder, true, true>(F.lds + RING_OFF, g, S, E);
        if (BOTH(7)) XCC_BAR();
    }
    if (IN(8)) { REFRESH();
        pg8::Gemm g{TT, WD, MTOK, 1024, DFF, 1}; pg8::StaticOrder S; S.init(MTOK, 1024, G, bx);
        pg8::EpiRes E{args.out, args.out, 0};
        pg8::gemm_phase<pg8::EpiRes, pg8::StaticOrder, true, true>(F.lds + RING_OFF, g, S, E);
        if (BOTH(8)) XCC_BAR();
    }
    if (IN(9)) { REFRESH();
        const bool bad = __hip_atomic_load(F.ctl + CW_TMO, RLX_AGENT) != 0u || __hip_atomic_load((gu32*)(barw + XB_TMO), RLX_AGENT) != 0u;
        if (bad) { const float qn = __builtin_nanf("");
            for (int j = F.rank * NWAVES + F.wave; j < SEQ; j += 32 * NWAVES) { GAS f32x4* o = (GAS f32x4*)(args.out + (size_t)(F.xcc * SEQ + j) * DM) + F.lane;
#pragma unroll
                for (int q = 0; q < 4; ++q) o[64 * q] = (f32x4){qn, qn, qn, qn}; } }
        else ln_rows(F, args.out, args.in[13], args.in[14], args.out, nullptr);
    }
#undef IN
#undef BOTH
}

extern "C" void kernel_launch(void* const* d_in, const int* in_sizes, int n_in, void* d_out, int out_size, void* d_ws, size_t ws_size, hipStream_t stream) {
    static int grid = 0;
    if (grid == 0) {
        if (n_in != 15 || in_sizes[0] != MTOK * DM || out_size != MTOK * DM || ws_size < WS_END) {
            fprintf(stderr, "kernel_launch: unexpected problem: n_in %d in0 %d out %d ws %zu (need %zu); nothing launched\n", n_in, n_in > 0 ? in_sizes[0] : -1, out_size, ws_size, (size_t)WS_END); grid = -1; return; }
        int dev = 0, cus = 0, per_cu = 0;
        if (hipGetDevice(&dev) != hipSuccess || hipDeviceGetAttribute(&cus, hipDeviceAttributeMultiprocessorCount, dev) != hipSuccess) { fprintf(stderr, "kernel_launch: device query failed\n"); grid = -1; return; }
        if (hipFuncSetAttribute((const void*)skel_fwd, hipFuncAttributeMaxDynamicSharedMemorySize, LDS_BYTES) != hipSuccess) { fprintf(stderr, "kernel_launch: hipFuncSetAttribute failed\n"); grid = -1; return; }
        if (hipOccupancyMaxActiveBlocksPerMultiprocessor(&per_cu, (const void*)skel_fwd, NWAVES * 64, LDS_BYTES) != hipSuccess || per_cu < 1)
            fprintf(stderr, "kernel_launch: note: occupancy query reports %d workgroups per CU\n", per_cu);
        (void)hipGetLastError();
        grid = cus;
        if (grid != 256) fprintf(stderr, "kernel_launch: note: %d CUs (built for 256)\n", grid);
    }
    if (grid < 0) return;
    if (hipMemsetAsync((char*)d_ws + WS_CTL, 0, CTL_ZERO_BYTES, stream) != hipSuccess) { fprintf(stderr, "kernel_launch: memset failed\n"); return; }
    Args a{};
    for (int i = 0; i < 15; ++i) a.in[i] = (const float*)d_in[i];
    a.out = (float*)d_out; a.ws = (unsigned char*)d_ws;
    for (int li = 0; li < N_CUT_LAUNCHES; ++li) {
        a.ph_lo = CUTS[li]; a.ph_hi = CUTS[li + 1]; a.li = li;
        hipLaunchKernelGGL(skel_fwd, dim3(grid), dim3(NWAVES * 64), LDS_BYTES, stream, a);
        const hipError_t le = hipPeekAtLastError();
        if (le != hipSuccess) { fprintf(stderr, "kernel_launch: launch %d failed: %s\n", li, hipGetErrorName(le)); break; }
    }
}
```
